# Optimizing an MI355X kernel written in HIP

```python
import math
import jax, jax.numpy as jnp
from jax import lax
import numpy as np

D_MODEL = 1024
BATCH = 1
SEQ = 16384
DEPTH = 2

N_MIXERS = 2
N_A = (DEPTH + 1) // N_MIXERS
N_B = DEPTH // N_MIXERS

S5_WIDTH = D_MODEL
S5_GROUP = 16
S5_GROUPS = S5_WIDTH // S5_GROUP
S5_STATE = 64
S5_CHUNK = 128
S5_DT_MIN = 1e-3
S5_DT_MAX = 1e-1

N_HEADS = 8
HEAD_DIM = D_MODEL // N_HEADS
ATTN_WIDTH = N_HEADS * HEAD_DIM
MOBA_BLOCK = 256
MOBA_TOPK = 3
Q_BLOCK = 128
ROPE_THETA = 500000.0
ROT_DIM = HEAD_DIM // 4

D_FF = 2816
MACARON_WEIGHT = 0.5
EPS = 1e-6

kernel_name = 'hybrid_s5_moba_macaron'


def rms_norm(x, g):
    xf = x.astype(jnp.float32)
    y = xf * lax.rsqrt(jnp.mean(xf * xf, axis=-1, keepdims=True) + EPS)
    return (y * g.astype(jnp.float32)).astype(x.dtype)


def swiglu(h, w_gate, w_up, w_down):
    return (jax.nn.silu(h @ w_gate) * (h @ w_up)) @ w_down


def cmul(ar, ai, br, bi):
    return ar * br - ai * bi, ar * bi + ai * br


def s5_mixer(h, w_in, a_re, a_im, log_dt, b_re, b_im, c_re, c_im, d_skip, w_glu, w_out):
    f32 = jnp.float32
    bsz, seq, _ = h.shape
    u = (h @ w_in).astype(f32)
    dt = jnp.exp(log_dt.astype(f32))[:, None]
    a_re = a_re.astype(f32)
    a_im = a_im.astype(f32)
    mag = jnp.exp(a_re * dt)
    lam_re = mag * jnp.cos(a_im * dt)
    lam_im = mag * jnp.sin(a_im * dt)
    den = a_re * a_re + a_im * a_im
    num_re = lam_re - 1.0
    coef_re = (num_re * a_re + lam_im * a_im) / den
    coef_im = (lam_im * a_re - num_re * a_im) / den
    bb_re, bb_im = cmul(coef_re[..., None], coef_im[..., None], b_re.astype(f32), b_im.astype(f32))
    c_re = c_re.astype(f32)
    c_im = c_im.astype(f32)
    n_chunks = seq // S5_CHUNK
    u_chunks = u.reshape(bsz, n_chunks, S5_CHUNK, S5_GROUPS, S5_GROUP).transpose(1, 0, 2, 3, 4)
    lam_re_b = jnp.broadcast_to(lam_re, (bsz, S5_CHUNK, S5_GROUPS, S5_STATE))
    lam_im_b = jnp.broadcast_to(lam_im, (bsz, S5_CHUNK, S5_GROUPS, S5_STATE))

    def combine(left, right):
        a1r, a1i, b1r, b1i = left
        a2r, a2i, b2r, b2i = right
        ar, ai = cmul(a2r, a2i, a1r, a1i)
        br, bi = cmul(a2r, a2i, b1r, b1i)
        return ar, ai, br + b2r, bi + b2i

    def step(carry, u_c):
        h_re0, h_im0 = carry
        bu_re = jnp.einsum('bcgn,gpn->bcgp', u_c, bb_re)
        bu_im = jnp.einsum('bcgn,gpn->bcgp', u_c, bb_im)
        pr, pi, sr, si = lax.associative_scan(combine, (lam_re_b, lam_im_b, bu_re, bu_im), axis=1)
        cr, ci = cmul(pr, pi, h_re0[:, None], h_im0[:, None])
        st_re = sr + cr
        st_im = si + ci
        y = jnp.einsum('bcgp,gnp->bcgn', st_re, c_re) - jnp.einsum('bcgp,gnp->bcgn', st_im, c_im)
        return (st_re[:, -1], st_im[:, -1]), y

    init = (jnp.zeros((bsz, S5_GROUPS, S5_STATE), f32), jnp.zeros((bsz, S5_GROUPS, S5_STATE), f32))
    _, ys = lax.scan(step, init, u_chunks)
    y = ys.transpose(1, 0, 2, 3, 4).reshape(bsz, seq, S5_WIDTH) + d_skip.astype(f32) * u
    g = jax.nn.gelu(y)
    g = g * jax.nn.sigmoid(g @ w_glu.astype(f32))
    return g.astype(h.dtype) @ w_out


def partial_rope(x, cos, sin):
    half = ROT_DIM // 2
    x1 = x[..., :half]
    x2 = x[..., half:ROT_DIM]
    c = cos[None, :, None, :]
    s = sin[None, :, None, :]
    return jnp.concatenate([x1 * c - x2 * s, x2 * c + x1 * s, x[..., ROT_DIM:]], axis=-1)


def moba_mixer(h, w_qkv, q_gain, k_gain, w_out):
    f32 = jnp.float32
    bsz, seq, _ = h.shape
    qkv = (h @ w_qkv).reshape(bsz, seq, 3, N_HEADS, HEAD_DIM)
    q = rms_norm(qkv[:, :, 0], q_gain).astype(f32)
    k = rms_norm(qkv[:, :, 1], k_gain).astype(f32)
    v = qkv[:, :, 2].astype(f32)
    pos = jnp.arange(seq, dtype=f32)
    inv_freq = ROPE_THETA ** (-jnp.arange(0, ROT_DIM, 2, dtype=f32) / ROT_DIM)
    ang = pos[:, None] * inv_freq[None, :]
    cos, sin = jnp.cos(ang), jnp.sin(ang)
    q = partial_rope(q, cos, sin) * (HEAD_DIM ** -0.5)
    k = partial_rope(k, cos, sin)
    n_blocks = -(-seq // MOBA_BLOCK)
    pad = n_blocks * MOBA_BLOCK - seq
    k_pad = jnp.pad(k, ((0, 0), (0, pad), (0, 0), (0, 0)))
    v_pad = jnp.pad(v, ((0, 0), (0, pad), (0, 0), (0, 0)))
    k_blk = k_pad.reshape(bsz, n_blocks, MOBA_BLOCK, N_HEADS, HEAD_DIM)
    v_blk = v_pad.reshape(bsz, n_blocks, MOBA_BLOCK, N_HEADS, HEAD_DIM)
    k_mean = k_blk.mean(axis=2)
    k_bh = k_blk.transpose(0, 3, 1, 2, 4)
    v_bh = v_blk.transpose(0, 3, 1, 2, 4)
    top_k = min(MOBA_TOPK, n_blocks)
    b_idx = jnp.arange(bsz)[:, None, None]
    h_idx = jnp.arange(N_HEADS)[None, None, :]
    blk_ids = jnp.arange(n_blocks)

    def attend_chunk(c):
        start = c * Q_BLOCK
        q_c = lax.dynamic_slice_in_dim(q, start, Q_BLOCK, axis=1)
        q_pos = start + jnp.arange(Q_BLOCK)
        own = start // MOBA_BLOCK
        gate = jnp.einsum('bqhd,bnhd->bqhn', q_c, k_mean)
        gate = jnp.where(blk_ids < own, gate, -jnp.inf)
        _, sel = lax.top_k(gate, top_k)
        k_own = lax.dynamic_slice_in_dim(k_pad, own * MOBA_BLOCK, MOBA_BLOCK, axis=1)
        v_own = lax.dynamic_slice_in_dim(v_pad, own * MOBA_BLOCK, MOBA_BLOCK, axis=1)
        k_pos = own * MOBA_BLOCK + jnp.arange(MOBA_BLOCK)
        s_own = jnp.einsum('bqhd,bkhd->bqhk', q_c, k_own)
        causal = (k_pos[None, :] <= q_pos[:, None])[None, :, None, :]
        s_own = jnp.where(causal, s_own, -jnp.inf)
        scores = []
        for j in range(top_k):
            k_sel = k_bh[b_idx, h_idx, sel[..., j]]
            s_j = jnp.einsum('bqhd,bqhkd->bqhk', q_c, k_sel)
            scores.append(jnp.where(j < own, s_j, -jnp.inf))
        scores.append(s_own)
        p = jax.nn.softmax(jnp.concatenate(scores, axis=-1), axis=-1)
        p_parts = jnp.split(p, top_k + 1, axis=-1)
        out = jnp.einsum('bqhk,bkhd->bqhd', p_parts[-1], v_own)
        for j in range(top_k):
            v_sel = v_bh[b_idx, h_idx, sel[..., j]]
            out = out + jnp.einsum('bqhk,bqhkd->bqhd', p_parts[j], v_sel)
        return out

    outs = lax.map(attend_chunk, jnp.arange(seq // Q_BLOCK))
    o = outs.transpose(1, 0, 2, 3, 4).reshape(bsz, seq, ATTN_WIDTH).astype(h.dtype)
    return o @ w_out


def setup_inputs(seed: int = 0) -> dict:
    key = jax.random.key(seed)
    ks = jax.random.split(key, 24)
    f32 = jnp.float32
    nrm = lambda k, shape, scale: jax.random.normal(k, shape, f32) * scale
    x = nrm(ks[0], (BATCH, SEQ, D_MODEL), 1.0)
    ffn_norm = 1.0 + nrm(ks[1], (DEPTH, 2, D_MODEL), 0.02)
    ffn_w_gate = nrm(ks[2], (DEPTH, 2, D_MODEL, D_FF), D_MODEL ** -0.5)
    ffn_w_up = nrm(ks[3], (DEPTH, 2, D_MODEL, D_FF), D_MODEL ** -0.5)
    ffn_w_down = nrm(ks[4], (DEPTH, 2, D_FF, D_MODEL), D_FF ** -0.5)
    mix_norm = 1.0 + nrm(ks[5], (DEPTH, D_MODEL), 0.02)
    s5_w_in = nrm(ks[6], (N_A, D_MODEL, S5_WIDTH), D_MODEL ** -0.5)
    s5_a_re = -0.5 + nrm(ks[7], (N_A, S5_GROUPS, S5_STATE), 0.01)
    s5_a_im = math.pi * jnp.arange(S5_STATE, dtype=f32)[None, None, :] + nrm(ks[8], (N_A, S5_GROUPS, S5_STATE), 0.01)
    s5_log_dt = jax.random.uniform(ks[9], (N_A, S5_GROUPS), f32, math.log(S5_DT_MIN), math.log(S5_DT_MAX))
    s5_b_re = nrm(ks[10], (N_A, S5_GROUPS, S5_STATE, S5_GROUP), (2 * S5_GROUP) ** -0.5)
    s5_b_im = nrm(ks[11], (N_A, S5_GROUPS, S5_STATE, S5_GROUP), (2 * S5_GROUP) ** -0.5)
    s5_c_re = nrm(ks[12], (N_A, S5_GROUPS, S5_GROUP, S5_STATE), S5_STATE ** -0.5)
    s5_c_im = nrm(ks[13], (N_A, S5_GROUPS, S5_GROUP, S5_STATE), S5_STATE ** -0.5)
    s5_d = nrm(ks[14], (N_A, S5_WIDTH), 1.0)
    s5_w_glu = nrm(ks[15], (N_A, S5_WIDTH, S5_WIDTH), S5_WIDTH ** -0.5)
    s5_w_out = nrm(ks[16], (N_A, S5_WIDTH, D_MODEL), S5_WIDTH ** -0.5)
    moba_w_qkv = nrm(ks[17], (N_B, D_MODEL, 3 * ATTN_WIDTH), D_MODEL ** -0.5)
    moba_q_norm = 1.0 + nrm(ks[18], (N_B, HEAD_DIM), 0.02)
    moba_k_norm = 1.0 + nrm(ks[19], (N_B, HEAD_DIM), 0.02)
    moba_w_out = nrm(ks[20], (N_B, ATTN_WIDTH, D_MODEL), ATTN_WIDTH ** -0.5)
    return {'x': x, 'ffn_norm': ffn_norm, 'ffn_w_gate': ffn_w_gate, 'ffn_w_up': ffn_w_up,
            'ffn_w_down': ffn_w_down, 'mix_norm': mix_norm, 's5_w_in': s5_w_in,
            's5_a_re': s5_a_re, 's5_a_im': s5_a_im, 's5_log_dt': s5_log_dt,
            's5_b_re': s5_b_re, 's5_b_im': s5_b_im, 's5_c_re': s5_c_re, 's5_c_im': s5_c_im,
            's5_d': s5_d, 's5_w_glu': s5_w_glu, 's5_w_out': s5_w_out,
            'moba_w_qkv': moba_w_qkv, 'moba_q_norm': moba_q_norm, 'moba_k_norm': moba_k_norm,
            'moba_w_out': moba_w_out}


def reference(x, ffn_norm, ffn_w_gate, ffn_w_up, ffn_w_down, mix_norm, s5_w_in,
              s5_a_re, s5_a_im, s5_log_dt, s5_b_re, s5_b_im, s5_c_re, s5_c_im,
              s5_d, s5_w_glu, s5_w_out, moba_w_qkv, moba_q_norm, moba_k_norm, moba_w_out):
    h = x
    for layer in range(DEPTH):
        h = h + MACARON_WEIGHT * swiglu(rms_norm(h, ffn_norm[layer, 0]), ffn_w_gate[layer, 0],
                                        ffn_w_up[layer, 0], ffn_w_down[layer, 0])
        hn = rms_norm(h, mix_norm[layer])
        i = layer // N_MIXERS
        if layer % N_MIXERS == 0:
            h = h + s5_mixer(hn, s5_w_in[i], s5_a_re[i], s5_a_im[i], s5_log_dt[i], s5_b_re[i],
                             s5_b_im[i], s5_c_re[i], s5_c_im[i], s5_d[i], s5_w_glu[i], s5_w_out[i])
        else:
            h = h + moba_mixer(hn, moba_w_qkv[i], moba_q_norm[i], moba_k_norm[i], moba_w_out[i])
        h = h + MACARON_WEIGHT * swiglu(rms_norm(h, ffn_norm[layer, 1]), ffn_w_gate[layer, 1],
                                        ffn_w_up[layer, 1], ffn_w_down[layer, 1])
    return h
```

```cpp
#include <hip/hip_runtime.h>
#include <hip/hip_cooperative_groups.h>
#include <cstdio>
#include <cmath>
namespace cg = cooperative_groups;

#define LAS __attribute__((address_space(3)))
typedef unsigned short bf16_t;
typedef short bf16x8 __attribute__((ext_vector_type(8)));
typedef float f32x4 __attribute__((ext_vector_type(4)));
typedef float f32x16 __attribute__((ext_vector_type(16)));
typedef unsigned u32x4 __attribute__((ext_vector_type(4)));
typedef unsigned u32x2 __attribute__((ext_vector_type(2)));

constexpr int S = 16384, DM = 1024, FF = 2816, NH = 8;
constexpr float EPS = 1e-6f;
constexpr size_t MiB = 1048576;
constexpr size_t SZ_GU = (size_t)2 * FF * DM * 2, SZ_D = (size_t)DM * FF * 2, SZ_SQ = (size_t)DM * DM * 2, SZ_QKV = (size_t)3 * DM * DM * 2;
constexpr size_t W1_GU0 = 0, W1_D0 = W1_GU0 + SZ_GU, W1_QKV = W1_D0 + SZ_D, W1_MO = W1_QKV + SZ_QKV, W1_GU1 = W1_MO + SZ_SQ, W1_D1 = W1_GU1 + SZ_GU;
constexpr size_t WS_HB = 41 * MiB;
constexpr size_t WS_SMALL = 73 * MiB;
constexpr size_t WS_KMEAN = WS_SMALL;
constexpr size_t WS_CNT = WS_SMALL + 256 * 1024;
constexpr size_t WS_MSH = WS_CNT + 4096;
constexpr size_t WS_LPART = WS_SMALL + 512 * 1024;
constexpr size_t WS_BAR = WS_SMALL + 300 * 1024;
constexpr size_t WS_SSP = WS_SMALL + 2 * MiB;
constexpr size_t W0_GU0 = 76 * MiB, W0_D0 = W0_GU0 + SZ_GU, W0_IN = W0_D0 + SZ_D, W0_GLU = W0_IN + SZ_SQ, W0_OUT = W0_GLU + SZ_SQ, W0_GU1 = W0_OUT + SZ_SQ, W0_D1 = W0_GU1 + SZ_GU;
constexpr size_t WS_ACT = 115 * MiB;
constexpr size_t WS_U = 115 * MiB, WS_G = 147 * MiB, WS_EEND = 179 * MiB, WS_CARRY = 187 * MiB;
constexpr size_t WS_KN = 76 * MiB, WS_VT = 108 * MiB, WS_OPART = 140 * MiB, WS_QRAW = 140 * MiB, WS_VRAW = 172 * MiB, WS_LISTS = 236 * MiB;
constexpr size_t WS_QN = WS_HB;
constexpr size_t WS_ROPE = 252 * MiB;
constexpr int LDS_BYTES = 140 * 1024;

struct Params {
    const float *x, *ffn_norm, *w_gate, *w_up, *w_down, *mix_norm, *s5_w_in, *a_re, *a_im, *log_dt, *b_re, *b_im, *c_re, *c_im, *s5_d, *w_glu, *s5_w_out,
        *w_qkv, *q_gain, *k_gain, *mo_w_out;
    float* out; unsigned char* ws;
    float invf[16];
};

typedef const Params __attribute__((address_space(4)))* KP;
__device__ __forceinline__ int mytid() { int t = threadIdx.x; asm volatile("" : "+v"(t)); return t; }
__device__ __forceinline__ int mybid() { int b = blockIdx.x; asm volatile("" : "+s"(b)); return b; }
__device__ __forceinline__ unsigned cvt_pk_bf16(float lo, float hi) { unsigned r; asm volatile("v_cvt_pk_bf16_f32 %0, %1, %2" : "=v"(r) : "v"(lo), "v"(hi)); return r; }
__device__ __forceinline__ float bf_lo(unsigned v) { return __uint_as_float(v << 16); }
__device__ __forceinline__ float bf_hi(unsigned v) { return __uint_as_float(v & 0xffff0000u); }
__device__ __forceinline__ float wave_sum(float v) {
#pragma unroll
    for (int o = 1; o < 64; o <<= 1) v += __shfl_xor(v, o);
    return v;
}
__device__ __forceinline__ float fast_rcp(float x) { return __builtin_amdgcn_rcpf(x); }
__device__ __forceinline__ float sigmoidf_(float x) { return fast_rcp(1.f + __expf(-x)); }
__device__ __forceinline__ float gelu_tanh(float x) {
    const float z = 0.7978845608028654f * (x + 0.044715f * x * x * x);
    const float t = 1.f - 2.f * fast_rcp(__expf(2.f * z) + 1.f);
    return 0.5f * x * (1.f + t);
}

namespace pg8 {
constexpr int BM = 256, BK = 64, HALF = 128, HTB = HALF * BK * 2, STAGE_BYTES = 8 * HTB, NXCD = 8, WGM = 8;
__host__ __device__ __forceinline__ int lds_byte(int r, int c) { const int st = (r >> 4) * 2 + (c >> 5), rr = r & 15, cc = c & 31, ob = rr * 64 + cc * 2; return st * 1024 + (ob ^ (((ob >> 9) & 1) << 5)); }
__host__ __device__ __forceinline__ void stage_rc(int b, int& R, int& C) { const int st = b / 1024, sb = b % 1024, swz = sb ^ (((sb >> 9) & 1) << 5); R = (st >> 1) * 16 + swz / 64; C = (st & 1) * 32 + (swz % 64) / 2; }
__host__ __device__ __forceinline__ int perm32(int rho) { const int n = rho >> 4, i = rho & 15; return 8 * (i >> 2) + 4 * n + (i & 3); }
struct Unit { int pm, pn; };
struct Gemm { const bf16_t* A; const bf16_t* Bt; int M, N, K, lda; };
struct StaticOrder {
    int nM, nN, nwg, G, c;
    __device__ void init(int M, int N, int G_, int c_) { nM = M / BM; nN = N / BM; nwg = nM * nN; G = G_; c = c_; }
    __device__ bool next(int i, Unit& u) const {
        const long L = (long)i * G + c; if (L >= nwg) return false;
        int wgid = (int)L; { const int q = nwg / NXCD, r = nwg % NXCD, xcd = wgid % NXCD, off = wgid / NXCD; wgid = (xcd < r ? xcd * (q + 1) : r * (q + 1) + (xcd - r) * q) + off; }
        const int nig = WGM * nN, gid = wgid / nig, fm = gid * WGM, gsz = (nM - fm) < WGM ? (nM - fm) : WGM;
        u.pm = fm + ((wgid % nig) % gsz); u.pn = (wgid % nig) / gsz; return true;
    }
};
template <class Epi>
__device__ __forceinline__ void gemm_phase(LAS unsigned char* lds, const Gemm g, const StaticOrder& S_, const Epi& E) {
    const int tid = mytid(), wid = __builtin_amdgcn_readfirstlane(tid >> 6), lane = tid & 63, wr = wid >> 2, wc = wid & 3, fr = lane & 15, fq = lane >> 4;
    const int K = g.K, nt = K / BK, lda = g.lda;
    unsigned voffA[2], voffB[2];
#pragma unroll
    for (int i = 0; i < 2; ++i) { int R, C; stage_rc(tid * 16 + i * 8192, R, C); const int Rb = Epi::PERM ? ((R & ~31) + perm32(R & 31)) : R;
        voffA[i] = (unsigned)(R * lda + C) * 2u; voffB[i] = (unsigned)(Rb * K + C) * 2u; }
    const size_t kstep = (size_t)(BK * 2);
    const size_t hstepA = (size_t)HALF * lda * 2, hstepB = (size_t)HALF * K * 2;
    const size_t tstepA = 2 * hstepA, tstepB = 2 * hstepB;
    const unsigned ldsw = (unsigned)wid * 1024u;
    const int aoff = lds_byte(wr * 64 + fr, fq * 8), boff = lds_byte(wc * 32 + fr, fq * 8);
#define PG8_SA(b, h) (((b) * 2 + (h)) * HTB)
#define PG8_SB(b, h) ((4 + (b) * 2 + (h)) * HTB)
#define PG8_STAGE(bufoff, gbase, voff) do { _Pragma("unroll") for (int _i = 0; _i < 2; ++_i) \
        __builtin_amdgcn_global_load_lds((const unsigned*)((const char*)(gbase) + (voff)[_i]), (LAS unsigned*)(lds + (bufoff) + ldsw + _i * 8192), 16, 0, 0); } while (0)
#define PG8_LDA(dst, b, h) do { _Pragma("unroll") for (int m = 0; m < 4; ++m) _Pragma("unroll") for (int k = 0; k < 2; ++k) dst[m][k] = *(const LAS bf16x8*)(lds + PG8_SA(b, h) + aoff + m * 2048 + k * 1024); } while (0)
#define PG8_LDB(dst, b, h) do { _Pragma("unroll") for (int n = 0; n < 2; ++n) _Pragma("unroll") for (int k = 0; k < 2; ++k) dst[n][k] = *(const LAS bf16x8*)(lds + PG8_SB(b, h) + boff + n * 2048 + k * 1024); } while (0)
#define PG8_MMA(ai, bj, At, Bt) do { __builtin_amdgcn_s_setprio(1); _Pragma("unroll") for (int m = 0; m < 4; ++m) _Pragma("unroll") for (int n = 0; n < 2; ++n) _Pragma("unroll") for (int k = 0; k < 2; ++k) \
        acc[ai][bj][m][n] = __builtin_amdgcn_mfma_f32_16x16x32_bf16(Bt[n][k], At[m][k], acc[ai][bj][m][n], 0, 0, 0); __builtin_amdgcn_s_setprio(0); } while (0)
#define PG8_WAIT_V(n) asm volatile("s_waitcnt vmcnt(" #n ")" ::: "memory")
#define PG8_WAIT_L(n) asm volatile("s_waitcnt lgkmcnt(" #n ")" ::: "memory")
#define PG8_BAR __builtin_amdgcn_s_barrier()
#define PG8_SCHED __builtin_amdgcn_sched_barrier(0)
    Unit cur, nxt; int ui = 0;
    if (!S_.next(0, cur)) return;
    f32x4 acc[2][2][4][2];
#pragma unroll
    for (int a = 0; a < 2; ++a)
#pragma unroll
        for (int b = 0; b < 2; ++b)
#pragma unroll
            for (int m = 0; m < 4; ++m)
#pragma unroll
                for (int n = 0; n < 2; ++n) acc[a][b][m][n] = (f32x4){0.f, 0.f, 0.f, 0.f};
    bf16x8 At[4][2], B0[2][2], B1[2][2];
    const char* cA = (const char*)g.A + (size_t)cur.pm * tstepA; const char* cB = (const char*)g.Bt + (size_t)cur.pn * tstepB;
    typename Epi::IR ir;
    if constexpr (Epi::HAS_INIT) E.init_issue(ir, cur, wr, wc, fr, fq);
    PG8_STAGE(PG8_SB(0, 0), cB, voffB); PG8_STAGE(PG8_SA(0, 0), cA, voffA); PG8_STAGE(PG8_SB(0, 1), cB + hstepB, voffB); PG8_STAGE(PG8_SA(0, 1), cA + hstepA, voffA);
    if (wr == 1) PG8_BAR;
    PG8_WAIT_V(4); PG8_BAR;
    PG8_STAGE(PG8_SB(1, 0), cB + kstep, voffB); PG8_STAGE(PG8_SA(1, 0), cA + kstep, voffA); PG8_STAGE(PG8_SB(1, 1), cB + hstepB + kstep, voffB);
    PG8_WAIT_V(6); PG8_BAR;
    if constexpr (Epi::HAS_INIT) E.init_finish(acc, ir);
    for (;;) {
        const bool has_next = S_.next(ui + 1, nxt);
        const char* nA = has_next ? (const char*)g.A + (size_t)nxt.pm * tstepA : cA; const char* nB = has_next ? (const char*)g.Bt + (size_t)nxt.pn * tstepB : cB;
        for (int t = 0; t < nt; t += 2) {
            const bool last = (t == nt - 2);
            const char* a1 = cA + (size_t)(t + 1) * kstep;
            const char* a2 = last ? nA : cA + (size_t)(t + 2) * kstep; const char* b2 = last ? nB : cB + (size_t)(t + 2) * kstep;
            const char* a3 = a2 + kstep; const char* b3 = b2 + kstep;
            PG8_LDB(B0, 0, 0); PG8_SCHED; PG8_LDA(At, 0, 0); PG8_STAGE(PG8_SA(1, 1), a1 + hstepA, voffA);
            PG8_WAIT_L(8); PG8_BAR; PG8_WAIT_L(0); PG8_MMA(0, 0, At, B0); PG8_BAR; PG8_SCHED;
            PG8_LDB(B1, 0, 1); PG8_STAGE(PG8_SB(0, 0), b2, voffB);
            PG8_BAR; PG8_WAIT_L(0); PG8_MMA(0, 1, At, B1); PG8_BAR;
            PG8_LDA(At, 0, 1); PG8_STAGE(PG8_SA(0, 0), a2, voffA);
            PG8_BAR; PG8_WAIT_L(0); PG8_MMA(1, 0, At, B0); PG8_BAR; PG8_SCHED;
            PG8_STAGE(PG8_SB(0, 1), b2 + hstepB, voffB);
            PG8_WAIT_V(6); PG8_BAR; PG8_MMA(1, 1, At, B1); PG8_BAR;
            PG8_LDB(B0, 1, 0); PG8_SCHED; PG8_LDA(At, 1, 0); PG8_STAGE(PG8_SA(0, 1), a2 + hstepA, voffA);
            PG8_WAIT_L(8); PG8_BAR; PG8_WAIT_L(0); PG8_MMA(0, 0, At, B0); PG8_BAR; PG8_SCHED;
            PG8_LDB(B1, 1, 1); PG8_STAGE(PG8_SB(1, 0), b3, voffB);
            PG8_BAR; PG8_WAIT_L(0); PG8_MMA(0, 1, At, B1); PG8_BAR;
            PG8_LDA(At, 1, 1); PG8_STAGE(PG8_SA(1, 0), a3, voffA);
            PG8_BAR; PG8_WAIT_L(0); PG8_MMA(1, 0, At, B0); PG8_BAR; PG8_SCHED;
            PG8_STAGE(PG8_SB(1, 1), b3 + hstepB, voffB);
            PG8_WAIT_V(6); PG8_BAR; PG8_MMA(1, 1, At, B1); PG8_BAR;
        }
        E(acc, cur, wr, wc, fr, fq);
        if (!has_next) break;
#pragma unroll
        for (int a = 0; a < 2; ++a)
#pragma unroll
            for (int b = 0; b < 2; ++b)
#pragma unroll
                for (int m = 0; m < 4; ++m)
#pragma unroll
                    for (int n = 0; n < 2; ++n) acc[a][b][m][n] = (f32x4){0.f, 0.f, 0.f, 0.f};
        if constexpr (Epi::HAS_INIT) { E.init_issue(ir, nxt, wr, wc, fr, fq); E.init_finish(acc, ir); }
        cur = nxt; cA = nA; cB = nB; ++ui;
    }
    PG8_WAIT_V(0);
    if (wr == 0) PG8_BAR;
    PG8_BAR;
#undef PG8_SA
#undef PG8_SB
#undef PG8_STAGE
#undef PG8_LDA
#undef PG8_LDB
#undef PG8_MMA
#undef PG8_WAIT_V
#undef PG8_WAIT_L
#undef PG8_BAR
#undef PG8_SCHED
}
}
using pg8::Unit;
typedef const f32x4 (&AccRef)[2][2][4][2];
typedef f32x4 (&AccMut)[2][2][4][2];

__device__ __forceinline__ void st16_wt(void* base, int bytes, unsigned off, u32x4 v) { __builtin_amdgcn_raw_buffer_store_b128(v, __builtin_amdgcn_make_buffer_rsrc(base, (short)0, bytes, 0x00020000), off, 0, 16); }
__device__ __forceinline__ void st8_wt(void* base, int bytes, unsigned off, u32x2 v) { __builtin_amdgcn_raw_buffer_store_b64(v, __builtin_amdgcn_make_buffer_rsrc(base, (short)0, bytes, 0x00020000), off, 0, 16); }
__device__ __forceinline__ float row_rstd(const float* ssp, int r) {
    const f32x4* q = (const f32x4*)(ssp + (size_t)r * 16); const f32x4 a = q[0], b = q[1], c = q[2], d = q[3];
    const float s = ((a[0] + a[1]) + (a[2] + a[3])) + ((b[0] + b[1]) + (b[2] + b[3])) + ((c[0] + c[1]) + (c[2] + c[3])) + ((d[0] + d[1]) + (d[2] + d[3]));
    return rsqrtf(s * (1.f / DM) + EPS);
}
constexpr int RS_LDS_OFF = 131072;
__device__ __forceinline__ int rs_table_build(unsigned char* shm, const float* ssp, int N) {
    pg8::StaticOrder so; so.init(S, N, gridDim.x, mybid()); pg8::Unit u0; int pm0 = -1;
    if (so.next(0, u0)) pm0 = u0.pm;
    const int t = mytid();
    if (pm0 >= 0 && t < 256) ((float*)(shm + RS_LDS_OFF))[t] = row_rstd(ssp, pm0 * 256 + t);
    __syncthreads();
    return pm0;
}
__device__ __forceinline__ float rs_get(const float* rsl, int pm0, const float* ssp, int pm, int r) { return pm == pm0 ? rsl[r - pm0 * 256] : row_rstd(ssp, r); }
struct EpiGU {
    static constexpr bool PERM = true, HAS_INIT = false; struct IR {};
    bf16_t* act; const float* ss; const float* rsl; int pm0;
    __device__ __forceinline__ void operator()(AccRef acc, const Unit& u, int wr, int wc, int fr, int fq) const {
        const int row0 = u.pm * 256 + wr * 64 + fr, col0 = u.pn * 128 + wc * 32 + 8 * fq;
#pragma unroll
        for (int ai = 0; ai < 2; ++ai)
#pragma unroll
            for (int m = 0; m < 4; ++m) {
                const int r = row0 + ai * 128 + m * 16; const float rs = rs_get(rsl, pm0, ss, u.pm, r);
                float v[8];
#pragma unroll
                for (int n = 0; n < 2; ++n)
#pragma unroll
                    for (int i = 0; i < 4; ++i) { const float gt = acc[ai][0][m][n][i] * rs, up = acc[ai][1][m][n][i] * rs; v[n * 4 + i] = gt * sigmoidf_(gt) * up; }
                u32x4 o; o.x = cvt_pk_bf16(v[0], v[1]); o.y = cvt_pk_bf16(v[2], v[3]); o.z = cvt_pk_bf16(v[4], v[5]); o.w = cvt_pk_bf16(v[6], v[7]);
                st16_wt(act, S * FF * 2, (unsigned)(r * FF + col0) * 2u, o);
            }
    }
};
struct EpiRes {
    static constexpr bool PERM = false, HAS_INIT = true;
    float* fout; bf16_t* hb; float* ss; float w;
    struct IR { u32x2 v[2][4][2][2]; };
    __device__ __forceinline__ void init_issue(IR& ir, const Unit& u, int wr, int wc, int fr, int fq) const {
        const int row0 = u.pm * 256 + wr * 64 + fr, col0 = u.pn * 256 + wc * 32 + 4 * fq;
#pragma unroll
        for (int ai = 0; ai < 2; ++ai)
#pragma unroll
            for (int m = 0; m < 4; ++m)
#pragma unroll
                for (int bj = 0; bj < 2; ++bj)
#pragma unroll
                    for (int n = 0; n < 2; ++n) ir.v[ai][m][bj][n] = *(const u32x2*)(hb + (size_t)(row0 + ai * 128 + m * 16) * DM + col0 + bj * 128 + n * 16);
    }
    __device__ __forceinline__ void init_finish(AccMut acc, const IR& ir) const {
        const float iw = 1.f / w;
#pragma unroll
        for (int ai = 0; ai < 2; ++ai)
#pragma unroll
            for (int m = 0; m < 4; ++m)
#pragma unroll
                for (int bj = 0; bj < 2; ++bj)
#pragma unroll
                    for (int n = 0; n < 2; ++n) { const u32x2 v = ir.v[ai][m][bj][n]; acc[ai][bj][m][n] = (f32x4){bf_lo(v.x) * iw, bf_hi(v.x) * iw, bf_lo(v.y) * iw, bf_hi(v.y) * iw}; }
    }
    __device__ __forceinline__ void operator()(AccRef acc, const Unit& u, int wr, int wc, int fr, int fq) const {
        const int row0 = u.pm * 256 + wr * 64 + fr, col0 = u.pn * 256 + wc * 32 + 4 * fq;
#pragma unroll
        for (int ai = 0; ai < 2; ++ai) {
#pragma unroll
            for (int m = 0; m < 4; ++m) {
                const int r = row0 + ai * 128 + m * 16; float sq = 0.f;
#pragma unroll
                for (int bj = 0; bj < 2; ++bj)
#pragma unroll
                    for (int n = 0; n < 2; ++n) {
                        const size_t idx = (size_t)r * DM + col0 + bj * 128 + n * 16;
                        const f32x4 h = acc[ai][bj][m][n] * w;
                        if (fout) st16_wt(fout, S * DM * 4, (unsigned)idx * 4u, __builtin_bit_cast(u32x4, h));
                        else { u32x2 o; o.x = cvt_pk_bf16(h[0], h[1]); o.y = cvt_pk_bf16(h[2], h[3]); st8_wt(hb, S * DM * 2, (unsigned)idx * 2u, o); }
                        sq += h[0] * h[0] + h[1] * h[1] + h[2] * h[2] + h[3] * h[3];
                    }
                if (!fout) { sq += __shfl_xor(sq, 16); sq += __shfl_xor(sq, 32); if (fq == 0) ss[(size_t)r * 16 + u.pn * 4 + wc] = sq; }
            }
        }
    }
};
struct EpiU {
    static constexpr bool PERM = true, HAS_INIT = false; struct IR {};
    bf16_t* o; const float* ss; const float* rsl; int pm0;
    __device__ __forceinline__ void operator()(AccRef acc, const Unit& u, int wr, int wc, int fr, int fq) const {
        const int row0 = u.pm * 256 + wr * 64 + fr, col0 = u.pn * 256 + wc * 32 + 8 * fq;
#pragma unroll
        for (int ai = 0; ai < 2; ++ai)
#pragma unroll
            for (int m = 0; m < 4; ++m) {
                const int r = row0 + ai * 128 + m * 16; const float rs = rs_get(rsl, pm0, ss, u.pm, r);
#pragma unroll
                for (int bj = 0; bj < 2; ++bj) { const f32x4 a = acc[ai][bj][m][0] * rs, b = acc[ai][bj][m][1] * rs;
                    u32x4 v; v.x = cvt_pk_bf16(a[0], a[1]); v.y = cvt_pk_bf16(a[2], a[3]); v.z = cvt_pk_bf16(b[0], b[1]); v.w = cvt_pk_bf16(b[2], b[3]);
                    st16_wt(o, S * DM * 2, (unsigned)(r * DM + col0 + bj * 128) * 2u, v); }
            }
    }
};
struct EpiGLU {
    static constexpr bool PERM = true, HAS_INIT = false; struct IR {};
    const bf16_t* g; bf16_t* o;
    __device__ __forceinline__ void operator()(AccRef acc, const Unit& u, int wr, int wc, int fr, int fq) const {
        const int row0 = u.pm * 256 + wr * 64 + fr, col0 = u.pn * 256 + wc * 32 + 8 * fq;
#pragma unroll
        for (int ai = 0; ai < 2; ++ai) {
            u32x4 gvv[4][2];
#pragma unroll
            for (int m = 0; m < 4; ++m)
#pragma unroll
                for (int bj = 0; bj < 2; ++bj) gvv[m][bj] = *(const u32x4*)(g + (size_t)(row0 + ai * 128 + m * 16) * DM + col0 + bj * 128);
#pragma unroll
            for (int m = 0; m < 4; ++m) {
                const int r = row0 + ai * 128 + m * 16;
#pragma unroll
                for (int bj = 0; bj < 2; ++bj) { const size_t idx = (size_t)r * DM + col0 + bj * 128; const u32x4 gv = gvv[m][bj];
                    const f32x4 a = acc[ai][bj][m][0], b = acc[ai][bj][m][1];
                    u32x4 v; v.x = cvt_pk_bf16(bf_lo(gv.x) * sigmoidf_(a[0]), bf_hi(gv.x) * sigmoidf_(a[1])); v.y = cvt_pk_bf16(bf_lo(gv.y) * sigmoidf_(a[2]), bf_hi(gv.y) * sigmoidf_(a[3]));
                    v.z = cvt_pk_bf16(bf_lo(gv.z) * sigmoidf_(b[0]), bf_hi(gv.z) * sigmoidf_(b[1])); v.w = cvt_pk_bf16(bf_lo(gv.w) * sigmoidf_(b[2]), bf_hi(gv.w) * sigmoidf_(b[3]));
                    st16_wt(o, S * DM * 2, (unsigned)idx * 2u, v); }
            }
        }
    }
};
struct EpiQKV {
    static constexpr bool PERM = true, HAS_INIT = false; struct IR {};
    unsigned char* ws; const float* ss; const float* rsl; int pm0;
    __device__ __forceinline__ void operator()(AccRef acc, const Unit& u, int wr, int wc, int fr, int fq) const {
        const int row0 = u.pm * 256 + wr * 64 + fr, t = u.pn >> 2; const size_t boff = t == 0 ? WS_QRAW : (t == 1 ? WS_KN : WS_VRAW); bf16_t* base = (bf16_t*)(ws + boff);
        const int d0 = wc * 32 + 8 * fq;
#pragma unroll
        for (int ai = 0; ai < 2; ++ai)
#pragma unroll
            for (int m = 0; m < 4; ++m) {
                const int r = row0 + ai * 128 + m * 16; const float rs = rs_get(rsl, pm0, ss, u.pm, r);
#pragma unroll
                for (int bj = 0; bj < 2; ++bj) { const int h = (u.pn & 3) * 2 + bj; const f32x4 a = acc[ai][bj][m][0] * rs, b = acc[ai][bj][m][1] * rs;
                    u32x4 vv; vv.x = cvt_pk_bf16(a[0], a[1]); vv.y = cvt_pk_bf16(a[2], a[3]); vv.z = cvt_pk_bf16(b[0], b[1]); vv.w = cvt_pk_bf16(b[2], b[3]);
                    st16_wt(base, S * DM * 2, (unsigned)((h * S + r) * 128 + d0) * 2u, vv); }
            }
    }
};

__device__ __forceinline__ void wave_lds_sync() { asm volatile("s_waitcnt lgkmcnt(0)" ::: "memory"); __builtin_amdgcn_wave_barrier(); }
__device__ __forceinline__ void p0_transpose_item(const float* W, int K, int N, bf16_t* WT, const float* sc, int gu, int roff, float* scr, int item, int lane) {
    const int nblk = N / 32, kb = item / nblk, nb = item % nblk, k0 = 64 * kb, n0 = 32 * nb;
    float wv[32];
#pragma unroll
    for (int i = 0; i < 32; ++i) wv[i] = __builtin_nontemporal_load(&W[(size_t)(k0 + 2 * i + (lane >> 5)) * N + n0 + (lane & 31)]);
#pragma unroll
    for (int i = 0; i < 32; ++i) { const int kk = 2 * i + (lane >> 5); float v = wv[i]; if (sc) v *= sc[k0 + kk]; scr[kk * 33 + (lane & 31)] = v; }
    wave_lds_sync();
    const int c = lane & 7;
#pragma unroll
    for (int j = 0; j < 4; ++j) { const int n = (lane >> 3) + 8 * j; const float* s = scr + (8 * c) * 33 + n;
        u32x4 o; o.x = cvt_pk_bf16(s[0 * 33], s[1 * 33]); o.y = cvt_pk_bf16(s[2 * 33], s[3 * 33]); o.z = cvt_pk_bf16(s[4 * 33], s[5 * 33]); o.w = cvt_pk_bf16(s[6 * 33], s[7 * 33]);
        const int nn = n0 + n; const int row = gu ? ((nn >> 7) * 256 + roff + (nn & 127)) : nn;
        *(u32x4*)(WT + (size_t)row * K + k0 + 8 * c) = o; }
    wave_lds_sync();
}
__device__ __forceinline__ void prep_weights(KP p, unsigned char* shm, int stage, int widx, int nw) {
    const int tid = mytid(), wave = tid >> 6, lane = tid & 63;
    float* scr = (float*)(shm + wave * 16384);
    unsigned char* ws = p->ws;
    constexpr int I_FF = (DM / 64) * (FF / 32), I_D = (FF / 64) * (DM / 32), I_SQ = (DM / 64) * (DM / 32), I_QKV = (DM / 64) * (3 * DM / 32);
    constexpr int F1 = 2 * I_FF + I_D, NITEMS = 4 * F1 + 4 * I_SQ + I_QKV;
    const int lo1 = stage == 0 ? 0 : (stage == 1 ? 2 * I_FF : (stage == 2 ? 2 * F1 : 3 * F1)), hi1 = stage == 0 ? 2 * I_FF : (stage == 1 ? 2 * F1 : (stage == 2 ? 3 * F1 : 4 * F1));
    const int lo2 = stage == 1 ? 4 * F1 : (stage == 2 ? 4 * F1 + 3 * I_SQ : 0), hi2 = stage == 1 ? 4 * F1 + 3 * I_SQ : (stage == 2 ? NITEMS : 0);
    const int n1 = hi1 - lo1, ntot = n1 + (hi2 - lo2);
    for (int v = widx; v < ntot; v += nw) {
        const int it = v < n1 ? lo1 + v : lo2 + (v - n1);
        int r = it;
        if (r < 4 * (2 * I_FF + I_D)) {
            const int f = r / (2 * I_FF + I_D); r -= f * (2 * I_FF + I_D);
            const size_t gu_off = f == 0 ? W0_GU0 : (f == 1 ? W0_GU1 : (f == 2 ? W1_GU0 : W1_GU1));
            const size_t d_off = f == 0 ? W0_D0 : (f == 1 ? W0_D1 : (f == 2 ? W1_D0 : W1_D1));
            if (r < I_FF) p0_transpose_item(p->w_gate + (size_t)f * DM * FF, DM, FF, (bf16_t*)(ws + gu_off), p->ffn_norm + f * DM, 1, 0, scr, r, lane);
            else if (r < 2 * I_FF) p0_transpose_item(p->w_up + (size_t)f * DM * FF, DM, FF, (bf16_t*)(ws + gu_off), p->ffn_norm + f * DM, 1, 128, scr, r - I_FF, lane);
            else p0_transpose_item(p->w_down + (size_t)f * DM * FF, FF, DM, (bf16_t*)(ws + d_off), nullptr, 0, 0, scr, r - 2 * I_FF, lane);
            continue;
        }
        r -= 4 * (2 * I_FF + I_D);
        if (r < I_SQ) { p0_transpose_item(p->s5_w_in, DM, DM, (bf16_t*)(ws + W0_IN), p->mix_norm, 0, 0, scr, r, lane); continue; } r -= I_SQ;
        if (r < I_SQ) { p0_transpose_item(p->w_glu, DM, DM, (bf16_t*)(ws + W0_GLU), nullptr, 0, 0, scr, r, lane); continue; } r -= I_SQ;
        if (r < I_SQ) { p0_transpose_item(p->s5_w_out, DM, DM, (bf16_t*)(ws + W0_OUT), nullptr, 0, 0, scr, r, lane); continue; } r -= I_SQ;
        if (r < I_SQ) { p0_transpose_item(p->mo_w_out, DM, DM, (bf16_t*)(ws + W1_MO), nullptr, 0, 0, scr, r, lane); continue; } r -= I_SQ;
        p0_transpose_item(p->w_qkv, DM, 3 * DM, (bf16_t*)(ws + W1_QKV), p->mix_norm + DM, 0, 0, scr, r, lane);
    }
    if (stage == 2) { float2* rope = (float2*)(ws + WS_ROPE);
        for (int i = widx * 64 + lane; i < S * 16; i += nw * 64) { const float ang = (float)(i >> 4) * p->invf[i & 15]; rope[i] = make_float2(cosf(ang), sinf(ang)); } }
}
__device__ __forceinline__ void phase_prep(KP p, unsigned char* shm) {
    const int tid = mytid(), wave = tid >> 6, lane = tid & 63;
    const int gw = mybid() * 8 + wave, NGW = gridDim.x * 8;
    unsigned char* ws = p->ws;
    prep_weights(p, shm, 0, gw, NGW);
    float* rowss = (float*)(ws + WS_SSP); bf16_t* hb = (bf16_t*)(ws + WS_HB);
    for (int row0 = gw * 4; row0 < S; row0 += NGW * 4) {
        f32x4 xv[4][4];
#pragma unroll
        for (int q = 0; q < 4; ++q)
#pragma unroll
            for (int j = 0; j < 4; ++j) xv[q][j] = __builtin_nontemporal_load(((const f32x4*)(p->x + (size_t)(row0 + q) * DM) + lane) + 64 * j);
#pragma unroll
        for (int q = 0; q < 4; ++q) { const int row = row0 + q; float s = 0.f;
#pragma unroll
            for (int j = 0; j < 4; ++j) { const f32x4 v = xv[q][j]; s += v[0] * v[0] + v[1] * v[1] + v[2] * v[2] + v[3] * v[3];
                u32x2 o; o.x = cvt_pk_bf16(v[0], v[1]); o.y = cvt_pk_bf16(v[2], v[3]); *((u32x2*)(hb + (size_t)row * DM) + lane + 64 * j) = o; }
            s = wave_sum(s); if (lane < 16) rowss[(size_t)row * 16 + lane] = lane == 0 ? s : 0.f; }
    }
    if (mybid() == 0) {
        ((int*)(ws + WS_CNT))[tid] = 0;
        if (wave == 0) { float a = fmaxf(fabsf(p->q_gain[lane]), fabsf(p->q_gain[lane + 64])), b = fmaxf(fabsf(p->k_gain[lane]), fabsf(p->k_gain[lane + 64]));
#pragma unroll
            for (int o = 1; o < 64; o <<= 1) { a = fmaxf(a, __shfl_xor(a, o)); b = fmaxf(b, __shfl_xor(b, o)); }
            if (lane == 0) *(float*)(ws + WS_MSH) = 16.322231146f * a * b;   }
    }
}

__device__ __forceinline__ void s5_lambda(KP p, int g, int P, float& lr, float& li, float& cr, float& ci) {
    const float dt = expf(p->log_dt[g]); const float are = p->a_re[g * 64 + P], aim = p->a_im[g * 64 + P];
    const float mag = expf(are * dt), ang = aim * dt; lr = mag * cosf(ang); li = mag * sinf(ang);
    const float den = are * are + aim * aim, nre = lr - 1.f; cr = (nre * are + li * aim) / den; ci = (li * are - nre * aim) / den;
}
template <bool MAIN>
__device__ __forceinline__ void phase_s5_scan(KP p, unsigned char* shm) {
    const int tid = mytid(), wave = tid >> 6, lane = tid & 63, half = lane >> 5, sc = lane & 31;
    unsigned char* wl = shm + wave * (32 * 272);
    const int gw = mybid() * 8 + wave, NGW = gridDim.x * 8;
    const bf16_t* U = (const bf16_t*)(p->ws + WS_U); bf16_t* G = (bf16_t*)(p->ws + WS_G);
    float2* EEND = (float2*)(p->ws + WS_EEND); const float2* CARRY = (const float2*)(p->ws + WS_CARRY);
    const int g = gw & 63;
    float lr[2], li[2], xr[2], xi[2]; bf16x8 Bre[2], Bim[2];
#pragma unroll
        for (int s = 0; s < 2; ++s) {
            const int P = sc + 32 * s; float cr, ci; s5_lambda(p, g, P, lr[s], li[s], cr, ci);
            const f32x4* br = (const f32x4*)(p->b_re + ((size_t)(g * 64 + P) * 16 + half * 8)); const f32x4* bi = (const f32x4*)(p->b_im + ((size_t)(g * 64 + P) * 16 + half * 8));
            const f32x4 r0 = br[0], r1 = br[1], i0 = bi[0], i1 = bi[1];
            u32x4 a, b;
            a.x = cvt_pk_bf16(cr * r0[0] - ci * i0[0], cr * r0[1] - ci * i0[1]); a.y = cvt_pk_bf16(cr * r0[2] - ci * i0[2], cr * r0[3] - ci * i0[3]);
            a.z = cvt_pk_bf16(cr * r1[0] - ci * i1[0], cr * r1[1] - ci * i1[1]); a.w = cvt_pk_bf16(cr * r1[2] - ci * i1[2], cr * r1[3] - ci * i1[3]);
            b.x = cvt_pk_bf16(cr * i0[0] + ci * r0[0], cr * i0[1] + ci * r0[1]); b.y = cvt_pk_bf16(cr * i0[2] + ci * r0[2], cr * i0[3] + ci * r0[3]);
            b.z = cvt_pk_bf16(cr * i1[0] + ci * r1[0], cr * i1[1] + ci * r1[1]); b.w = cvt_pk_bf16(cr * i1[2] + ci * r1[2], cr * i1[3] + ci * r1[3]);
            Bre[s] = __builtin_bit_cast(bf16x8, a); Bim[s] = __builtin_bit_cast(bf16x8, b);
        }
        bf16x8 Cm[4]; float dsk[4];
        if (MAIN) {
            const int ch = lane & 15, q8 = lane >> 4; const float* cre = p->c_re + (size_t)(g * 16 + ch) * 64; const float* cim = p->c_im + (size_t)(g * 16 + ch) * 64;
#pragma unroll
            for (int ks = 0; ks < 4; ++ks) { const int s0 = ks * 8 + q8 * 2; u32x4 v;
                v.x = cvt_pk_bf16(cre[s0], cre[s0 + 32]); v.y = cvt_pk_bf16(-cim[s0], -cim[s0 + 32]); v.z = cvt_pk_bf16(cre[s0 + 1], cre[s0 + 33]); v.w = cvt_pk_bf16(-cim[s0 + 1], -cim[s0 + 33]);
                Cm[ks] = __builtin_bit_cast(bf16x8, v); }
#pragma unroll
            for (int j = 0; j < 4; ++j) dsk[j] = p->s5_d[g * 16 + q8 * 4 + j];
        }
    for (int cp = gw >> 6; cp < 128; cp += NGW >> 6) {
#pragma unroll
        for (int s = 0; s < 2; ++s) { if (MAIN) { const float2 c = CARRY[(size_t)(2 * cp + half) * 4096 + g * 64 + sc + 32 * s]; xr[s] = c.x; xi[s] = c.y; } else { xr[s] = 0.f; xi[s] = 0.f; } }
        const int ar = lane & 31, ahf = (ar >> 2) & 1, aidx = ((ar >> 3) << 2) | (ar & 3);
        bf16x8 apre[4]; u32x2 upre4[4][2];
#pragma unroll
        for (int i = 0; i < 4; ++i) { apre[i] = *(const bf16x8*)(U + (size_t)((2 * cp + ahf) * 64 + 16 * i + aidx) * DM + g * 16 + half * 8);
            if (MAIN) {
#pragma unroll
                for (int th = 0; th < 2; ++th) upre4[i][th] = *(const u32x2*)(U + (size_t)((2 * cp + th) * 64 + 16 * i + (lane & 15)) * DM + g * 16 + (lane >> 4) * 4); } }
#pragma unroll
        for (int i = 0; i < 4; ++i) {
            const bf16x8 a = apre[i];
            f32x16 are[2], aim[2];
#pragma unroll
            for (int s = 0; s < 2; ++s) { f32x16 z;
#pragma unroll
                for (int j = 0; j < 16; ++j) z[j] = 0.f;
                are[s] = __builtin_amdgcn_mfma_f32_32x32x16_bf16(a, Bre[s], z, 0, 0, 0); aim[s] = __builtin_amdgcn_mfma_f32_32x32x16_bf16(a, Bim[s], z, 0, 0, 0); }
#pragma unroll
            for (int j = 0; j < 16; ++j) {
#pragma unroll
                for (int s = 0; s < 2; ++s) { const float nr = lr[s] * xr[s] - li[s] * xi[s] + are[s][j], ni = lr[s] * xi[s] + li[s] * xr[s] + aim[s][j]; xr[s] = nr; xi[s] = ni; }
                if (MAIN) { u32x2 o; o.x = cvt_pk_bf16(xr[0], xr[1]); o.y = cvt_pk_bf16(xi[0], xi[1]); *(u32x2*)(wl + (half * 16 + j) * 272 + sc * 8) = o; }
            }
            if (MAIN) {
                wave_lds_sync();
                const int q8 = lane >> 4, tk = lane & 15;
#pragma unroll
                for (int th = 0; th < 2; ++th) {
                    f32x4 y = (f32x4){0.f, 0.f, 0.f, 0.f};
#pragma unroll
                    for (int ks = 0; ks < 4; ++ks) { const bf16x8 bfrag = *(const bf16x8*)(wl + (th * 16 + tk) * 272 + ks * 64 + q8 * 16); y = __builtin_amdgcn_mfma_f32_16x16x32_bf16(Cm[ks], bfrag, y, 0, 0, 0); }
                    const size_t idx = (size_t)((2 * cp + th) * 64 + 16 * i + tk) * DM + g * 16 + q8 * 4;
                    const u32x2 uu = upre4[i][th];
                    const float y0 = gelu_tanh(y[0] + dsk[0] * bf_lo(uu.x)), y1 = gelu_tanh(y[1] + dsk[1] * bf_hi(uu.x)), y2 = gelu_tanh(y[2] + dsk[2] * bf_lo(uu.y)), y3 = gelu_tanh(y[3] + dsk[3] * bf_hi(uu.y));
                    u32x2 o; o.x = cvt_pk_bf16(y0, y1); o.y = cvt_pk_bf16(y2, y3); *(u32x2*)(G + idx) = o;
                }
                wave_lds_sync();
            }
        }
        if (!MAIN) {
#pragma unroll
            for (int s = 0; s < 2; ++s) EEND[(size_t)(2 * cp + half) * 4096 + g * 64 + sc + 32 * s] = make_float2(xr[s], xi[s]);
        }
    }
}
__device__ __forceinline__ void phase_s5_carry(KP p, unsigned char* shm) {
    const int tid = mytid(), cl = tid & 31, seg = tid >> 5;
    const float2* EEND = (const float2*)(p->ws + WS_EEND); float2* CARRY = (float2*)(p->ws + WS_CARRY);
    float2* segend = (float2*)shm;
    for (int it = mybid(); it < 128; it += gridDim.x) {
        const int chn = it * 32 + cl; float lr, li, cr, ci; s5_lambda(p, chn >> 6, chn & 63, lr, li, cr, ci);
#pragma unroll
        for (int k = 0; k < 6; ++k) { const float a = lr * lr - li * li, b = 2.f * lr * li; lr = a; li = b; }
        float2 e[16];
#pragma unroll
        for (int i = 0; i < 16; ++i) e[i] = EEND[(size_t)(seg * 16 + i) * 4096 + chn];
        float xr = 0.f, xi = 0.f;
#pragma unroll
        for (int i = 0; i < 16; ++i) { const float nr = lr * xr - li * xi + e[i].x, ni = lr * xi + li * xr + e[i].y; xr = nr; xi = ni; }
        __syncthreads();
        segend[seg * 32 + cl] = make_float2(xr, xi);
        __syncthreads();
        float sr = lr, si = li;
#pragma unroll
        for (int k = 0; k < 4; ++k) { const float a = sr * sr - si * si, b = 2.f * sr * si; sr = a; si = b; }
        xr = 0.f; xi = 0.f;
        for (int s2 = 0; s2 < seg; ++s2) { const float2 v = segend[s2 * 32 + cl]; const float nr = sr * xr - si * xi + v.x, ni = sr * xi + si * xr + v.y; xr = nr; xi = ni; }
#pragma unroll
        for (int i = 0; i < 16; ++i) { CARRY[(size_t)(seg * 16 + i) * 4096 + chn] = make_float2(xr, xi); const float nr = lr * xr - li * xi + e[i].x, ni = lr * xi + li * xr + e[i].y; xr = nr; xi = ni; }
    }
}

__device__ __forceinline__ int list_off(int h, int n) { return h * 516096 + 256 * (63 * n - (n * (n - 1)) / 2); }
__device__ __forceinline__ void phase_qknorm(KP p, unsigned char* shm) {
    const int tid = mytid(), wave = tid >> 6, lane = tid & 63;
    const bf16_t* QRAW = (const bf16_t*)(p->ws + WS_QRAW); const bf16_t* VRAW = (const bf16_t*)(p->ws + WS_VRAW);
    bf16_t* QN = (bf16_t*)p->out; bf16_t* KN = (bf16_t*)(p->ws + WS_KN); bf16_t* VT = (bf16_t*)(p->ws + WS_VT); float* KMEAN = (float*)(p->ws + WS_KMEAN);
    const f32x4* ROPE = (const f32x4*)(p->ws + WS_ROPE);
    float* red = (float*)(shm + 256 * 272);
    const float gq0 = p->q_gain[2 * lane], gq1 = p->q_gain[2 * lane + 1], gk0 = p->k_gain[2 * lane], gk1 = p->k_gain[2 * lane + 1];
    for (int it = mybid(); it < 512; it += gridDim.x) {
        const int h = it & 7, n = it >> 3;
        float ka0 = 0.f, ka1 = 0.f;
        const size_t base = ((size_t)h * S + n * 256 + wave * 32) * 128 + 2 * lane;
        unsigned qv[4], kv[4]; f32x4 cs[4];
#pragma unroll
        for (int j = 0; j < 4; ++j) { qv[j] = __builtin_nontemporal_load((const unsigned*)(QRAW + base + (size_t)j * 128)); kv[j] = __builtin_nontemporal_load((const unsigned*)(KN + base + (size_t)j * 128)); cs[j] = ROPE[(size_t)(n * 256 + wave * 32 + j) * 8 + (lane & 7)]; }
        for (int g4 = 0; g4 < 8; ++g4) {
            unsigned qn_[4], kn_[4]; f32x4 cn_[4];
            if (g4 < 7) {
#pragma unroll
                for (int j = 0; j < 4; ++j) { const int rr = (g4 + 1) * 4 + j; qn_[j] = __builtin_nontemporal_load((const unsigned*)(QRAW + base + (size_t)rr * 128)); kn_[j] = __builtin_nontemporal_load((const unsigned*)(KN + base + (size_t)rr * 128)); cn_[j] = ROPE[(size_t)(n * 256 + wave * 32 + rr) * 8 + (lane & 7)]; }
            }
#pragma unroll
            for (int j = 0; j < 4; ++j) {
                const size_t idx = base + (size_t)(g4 * 4 + j) * 128;
                float q0 = bf_lo(qv[j]), q1 = bf_hi(qv[j]), k0 = bf_lo(kv[j]), k1 = bf_hi(kv[j]);
                const float rq = rsqrtf(wave_sum(q0 * q0 + q1 * q1) * (1.f / 128.f) + EPS), rk = rsqrtf(wave_sum(k0 * k0 + k1 * k1) * (1.f / 128.f) + EPS);
                q0 *= rq * gq0; q1 *= rq * gq1; k0 *= rk * gk0; k1 *= rk * gk1;
                const float pq0 = __shfl_xor(q0, 8), pq1 = __shfl_xor(q1, 8), pk0 = __shfl_xor(k0, 8), pk1 = __shfl_xor(k1, 8);
                if (lane < 16) {
                    const float c0 = cs[j][0], s0 = cs[j][1], c1 = cs[j][2], s1 = cs[j][3];
                    const float sg = lane < 8 ? -1.f : 1.f;
                    q0 = q0 * c0 + sg * pq0 * s0; q1 = q1 * c1 + sg * pq1 * s1; k0 = k0 * c0 + sg * pk0 * s0; k1 = k1 * c1 + sg * pk1 * s1;
                }
                *(unsigned*)(QN + idx) = cvt_pk_bf16(q0 * 0.1275174308f, q1 * 0.1275174308f);
                *(unsigned*)(KN + idx) = cvt_pk_bf16(k0, k1);
                ka0 += k0; ka1 += k1;
            }
#pragma unroll
            for (int j = 0; j < 4; ++j) { qv[j] = qn_[j]; kv[j] = kn_[j]; cs[j] = cn_[j]; }
        }
        __syncthreads();
        red[wave * 128 + 2 * lane] = ka0; red[wave * 128 + 2 * lane + 1] = ka1;
#pragma unroll
        for (int ps = 0; ps < 8; ++ps) { const int off = (ps * 512 + tid) * 16, key = off >> 8, cb = off & 255;
            *(u32x4*)(shm + key * 272 + cb) = __builtin_nontemporal_load((const u32x4*)((const unsigned char*)(VRAW + ((size_t)h * S + n * 256) * 128) + off)); }
        __syncthreads();
        if (tid < 128) { float s = 0.f;
#pragma unroll
            for (int w = 0; w < 8; ++w) s += red[w * 128 + tid];
            KMEAN[(size_t)(h * 64 + n) * 128 + tid] = s * (1.f / 256.f); }
        { const int d = tid & 127, kq = tid >> 7;
#pragma unroll
            for (int j = 0; j < 8; ++j) { unsigned short e[8];
#pragma unroll
                for (int k = 0; k < 8; ++k) e[k] = *(const unsigned short*)(shm + (kq * 64 + 8 * j + k) * 272 + d * 2);
                u32x4 o; o.x = e[0] | ((unsigned)e[1] << 16); o.y = e[2] | ((unsigned)e[3] << 16); o.z = e[4] | ((unsigned)e[5] << 16); o.w = e[6] | ((unsigned)e[7] << 16);
                *(u32x4*)(VT + ((size_t)(h * 64 + n) * 128 + d) * 256 + kq * 64 + 8 * j) = o; } }
    }
}
__device__ __forceinline__ void phase_gate(KP p, unsigned char* shm) {
    const int tid = mytid(), wave = tid >> 6, lane = tid & 63, qc = lane & 15, q4 = lane >> 4;
    const bf16_t* QN = (const bf16_t*)p->out; const float* KMEAN = (const float*)(p->ws + WS_KMEAN);
    int* CNT = (int*)(p->ws + WS_CNT); unsigned* LISTS = (unsigned*)(p->ws + WS_LISTS);
    int* cntl = (int*)shm; int* basel = cntl + 64;
    for (int it = mybid(); it < 1024; it += gridDim.x) {
        const int h = it & 7, c = it >> 3, own = c >> 1;
        __syncthreads();
        if (tid < 64) cntl[tid] = 0;
        __syncthreads();
        const int row = c * 128 + wave * 16 + qc;
        bf16x8 Qf[4];
#pragma unroll
        for (int ks = 0; ks < 4; ++ks) Qf[ks] = *(const bf16x8*)(QN + ((size_t)h * S + row) * 128 + ks * 32 + q4 * 8);
        const int nbt = (own + 15) >> 4;
        f32x4 gacc[4];
#pragma unroll
        for (int bt = 0; bt < 4; ++bt) {
            gacc[bt] = (f32x4){0.f, 0.f, 0.f, 0.f};
            if (bt < nbt) {
#pragma unroll
                for (int ks = 0; ks < 4; ++ks) {
                    const f32x4* kp = (const f32x4*)(KMEAN + (size_t)(h * 64 + bt * 16 + qc) * 128 + ks * 32 + q4 * 8); const f32x4 a = kp[0], b = kp[1];
                    u32x4 hi; hi.x = cvt_pk_bf16(a[0], a[1]); hi.y = cvt_pk_bf16(a[2], a[3]); hi.z = cvt_pk_bf16(b[0], b[1]); hi.w = cvt_pk_bf16(b[2], b[3]);
                    u32x4 lo; lo.x = cvt_pk_bf16(a[0] - bf_lo(hi.x), a[1] - bf_hi(hi.x)); lo.y = cvt_pk_bf16(a[2] - bf_lo(hi.y), a[3] - bf_hi(hi.y));
                    lo.z = cvt_pk_bf16(b[0] - bf_lo(hi.z), b[1] - bf_hi(hi.z)); lo.w = cvt_pk_bf16(b[2] - bf_lo(hi.w), b[3] - bf_hi(hi.w));
                    gacc[bt] = __builtin_amdgcn_mfma_f32_16x16x32_bf16(__builtin_bit_cast(bf16x8, hi), Qf[ks], gacc[bt], 0, 0, 0);
                    gacc[bt] = __builtin_amdgcn_mfma_f32_16x16x32_bf16(__builtin_bit_cast(bf16x8, lo), Qf[ks], gacc[bt], 0, 0, 0);
                }
            }
        }
        const float NINF = -__builtin_inff();
        float v0 = NINF, v1 = NINF, v2 = NINF; int i0 = 1000 + q4, i1 = 2000 + q4, i2 = 3000 + q4;
#pragma unroll
        for (int bt = 0; bt < 4; ++bt)
#pragma unroll
            for (int j = 0; j < 4; ++j) { const int n = bt * 16 + q4 * 4 + j; const float v = gacc[bt][j];
                if (n < own) {
                    if (v > v0) { v2 = v1; i2 = i1; v1 = v0; i1 = i0; v0 = v; i0 = n; }
                    else if (v > v1) { v2 = v1; i2 = i1; v1 = v; i1 = n; }
                    else if (v > v2) { v2 = v; i2 = n; } } }
        int sel[3];
#pragma unroll
        for (int j = 0; j < 3; ++j) { float bv = v0; int bi = i0;
#pragma unroll
            for (int o = 16; o < 64; o <<= 1) { const float ov = __shfl_xor(bv, o); const int oi = __shfl_xor(bi, o); if (ov > bv || (ov == bv && oi < bi)) { bv = ov; bi = oi; } }
            sel[j] = bi; if (bi == i0) { v0 = v1; i0 = i1; v1 = v2; i1 = i2; v2 = NINF; i2 = 4000 + q4; } }
        const int ns = own < 3 ? own : 3; int lpos[3] = {0, 0, 0};
        if (q4 == 0) {
#pragma unroll
            for (int j = 0; j < 3; ++j) if (j < ns) lpos[j] = atomicAdd(&cntl[sel[j]], 1);
        }
        __syncthreads();
        if (tid < 64) { const int cn = cntl[tid]; if (cn > 0) basel[tid] = atomicAdd(&CNT[h * 64 + tid], cn); }
        __syncthreads();
        if (q4 == 0) {
#pragma unroll
            for (int j = 0; j < 3; ++j) if (j < ns) LISTS[list_off(h, sel[j]) + basel[sel[j]] + lpos[j]] = ((unsigned)row << 2) | (unsigned)j;
        }
    }
}
struct AttnItem { int h, n, tile, cnt; };
template <bool OWN>
__device__ __forceinline__ AttnItem attn_decode(int it, const int* pre, const int* cnts) {
    AttnItem a;
    if (OWN) { a.h = it & 7; a.n = it >> 3; a.tile = a.n; a.cnt = 0; }
    else { int lo = 0, hi = 511; while (lo < hi) { const int mid = (lo + hi + 1) >> 1; if (pre[mid] <= it) lo = mid; else hi = mid - 1; }
        a.h = lo >> 6; a.n = lo & 63; a.tile = it - pre[lo]; a.cnt = cnts[lo]; }
    return a;
}
template <bool OWN>
__device__ __forceinline__ void phase_attn(KP p, unsigned char* shm) {
    const int tid = mytid(), wave = tid >> 6, lane = tid & 63, qc = lane & 15, q4 = lane >> 4;
    const bf16_t* QN = (const bf16_t*)p->out; const bf16_t* KN = (const bf16_t*)(p->ws + WS_KN); const bf16_t* VT = (const bf16_t*)(p->ws + WS_VT);
    bf16_t* OPART = (bf16_t*)(p->ws + WS_OPART); float* LPART = (float*)(p->ws + WS_LPART); const unsigned* LISTS = (const unsigned*)(p->ws + WS_LISTS);
    const float Msh = *(const float*)(p->ws + WS_MSH);
    unsigned char* Kl = shm; unsigned char* Vl = shm + 256 * 272;
    int* pre = (int*)(shm + 256 * 272 + 128 * 528); int* cnts = pre + 516;
    int total = 512;
    if (!OWN) {
        const int* CNT = (const int*)(p->ws + WS_CNT);
        const int mycnt = CNT[tid]; cnts[tid] = mycnt;
        pre[tid + 1] = (mycnt + 255) >> 8; if (tid == 0) pre[0] = 0;
        __syncthreads();
        for (int o = 1; o < 512; o <<= 1) { const int v = pre[tid + 1] + (tid >= o ? pre[tid + 1 - o] : 0); __syncthreads(); pre[tid + 1] = v; __syncthreads(); }
        total = pre[512];
    }
    const int G = gridDim.x;
    int it = mybid();
    if (!OWN && G == 256) it = ((it >> 5) << 5) | ((it & 7) << 2) | ((it >> 3) & 3);
    if (it >= total) return;
    AttnItem cur = attn_decode<OWN>(it, pre, cnts);
    const int r0 = wave * 32 + qc;
    unsigned ecur[2] = {0u, 0u}, enext[2] = {0u, 0u};
    if (!OWN) {
#pragma unroll
        for (int gq = 0; gq < 2; ++gq) { const int idx = cur.tile * 256 + r0 + 16 * gq; ecur[gq] = idx < cur.cnt ? (LISTS[list_off(cur.h, cur.n) + idx] | 0x80000000u) : 0u; }
        if (it + G < total) { const AttnItem nx = attn_decode<OWN>(it + G, pre, cnts);
#pragma unroll
            for (int gq = 0; gq < 2; ++gq) { const int i2 = nx.tile * 256 + r0 + 16 * gq; enext[gq] = i2 < nx.cnt ? (LISTS[list_off(nx.h, nx.n) + i2] | 0x80000000u) : 0u; } }
    }
    u32x4 kv[12]; bf16x8 Qf[2][4];
    {
#pragma unroll
        for (int gq = 0; gq < 2; ++gq) { const int qrow = OWN ? cur.tile * 256 + r0 + 16 * gq : (int)((ecur[gq] & 0x7fffffffu) >> 2);
#pragma unroll
            for (int ks = 0; ks < 4; ++ks) Qf[gq][ks] = *(const bf16x8*)(QN + ((size_t)cur.h * S + qrow) * 128 + ks * 32 + q4 * 8); }
        const unsigned char* kg_ = (const unsigned char*)(KN + ((size_t)cur.h * S + cur.n * 256) * 128); const unsigned char* vg_ = (const unsigned char*)(VT + (size_t)(cur.h * 64 + cur.n) * 128 * 256);
#pragma unroll
        for (int ps = 0; ps < 8; ++ps) { kv[ps] = *(const u32x4*)(kg_ + (ps * 512 + tid) * 16); if (ps < 4) kv[8 + ps] = *(const u32x4*)(vg_ + (ps * 512 + tid) * 16); } }
    for (;;) {
        __syncthreads();
        { u32x4 v2[4]; const unsigned char* vg_ = (const unsigned char*)(VT + (size_t)(cur.h * 64 + cur.n) * 128 * 256);
#pragma unroll
            for (int ps = 0; ps < 4; ++ps) v2[ps] = *(const u32x4*)(vg_ + ((4 + ps) * 512 + tid) * 16);
#pragma unroll
            for (int ps = 0; ps < 8; ++ps) { const int off = (ps * 512 + tid) * 16; *(u32x4*)(Kl + (off >> 8) * 272 + (off & 255)) = kv[ps]; if (ps < 4) *(u32x4*)(Vl + (off >> 9) * 528 + (off & 511)) = kv[8 + ps]; }
#pragma unroll
            for (int ps = 0; ps < 4; ++ps) { const int off = ((4 + ps) * 512 + tid) * 16; *(u32x4*)(Vl + (off >> 9) * 528 + (off & 511)) = v2[ps]; } }
        __syncthreads();
        const int itn = it + G; const bool has_next = itn < total;
        AttnItem nxt = cur; unsigned enn[2] = {0u, 0u};
        if (has_next) {
            nxt = attn_decode<OWN>(itn, pre, cnts);
            const unsigned char* kg_ = (const unsigned char*)(KN + ((size_t)nxt.h * S + nxt.n * 256) * 128); const unsigned char* vg_ = (const unsigned char*)(VT + (size_t)(nxt.h * 64 + nxt.n) * 128 * 256);
#pragma unroll
            for (int ps = 0; ps < 8; ++ps) { kv[ps] = *(const u32x4*)(kg_ + (ps * 512 + tid) * 16); if (ps < 4) kv[8 + ps] = *(const u32x4*)(vg_ + (ps * 512 + tid) * 16); }
            if (!OWN && itn + G < total) { const AttnItem n2 = attn_decode<OWN>(itn + G, pre, cnts);
#pragma unroll
                for (int gq = 0; gq < 2; ++gq) { const int i2 = n2.tile * 256 + r0 + 16 * gq; enn[gq] = i2 < n2.cnt ? (LISTS[list_off(n2.h, n2.n) + i2] | 0x80000000u) : 0u; } }
        }
        const int h = cur.h, n = cur.n;
        int qrow[2];
#pragma unroll
        for (int gq = 0; gq < 2; ++gq) qrow[gq] = OWN ? cur.tile * 256 + r0 + 16 * gq : (int)((ecur[gq] & 0x7fffffffu) >> 2);
        float lsum[2] = {0.f, 0.f}; f32x4 o[2][8];
#pragma unroll
        for (int gq = 0; gq < 2; ++gq)
#pragma unroll
            for (int dt = 0; dt < 8; ++dt) o[gq][dt] = (f32x4){0.f, 0.f, 0.f, 0.f};
        const int kg_end = OWN ? wave + 1 : ((cur.tile * 256 + wave * 32 < cur.cnt) ? 8 : 0);
#pragma unroll 2
        for (int kg = 0; kg < kg_end; ++kg) {
            f32x4 sa[2], sb[2];
#pragma unroll
            for (int gq = 0; gq < 2; ++gq) { sa[gq] = (f32x4){-Msh, -Msh, -Msh, -Msh}; sb[gq] = sa[gq]; }
            const int key_a = kg * 32 + (qc >> 2) * 8 + (qc & 3);
#pragma unroll
            for (int ks = 0; ks < 4; ++ks) { const bf16x8 Ka = *(const bf16x8*)(Kl + key_a * 272 + (ks * 32 + q4 * 8) * 2), Kb = *(const bf16x8*)(Kl + (key_a + 4) * 272 + (ks * 32 + q4 * 8) * 2);
#pragma unroll
                for (int gq = 0; gq < 2; ++gq) { sa[gq] = __builtin_amdgcn_mfma_f32_16x16x32_bf16(Ka, Qf[gq][ks], sa[gq], 0, 0, 0); sb[gq] = __builtin_amdgcn_mfma_f32_16x16x32_bf16(Kb, Qf[gq][ks], sb[gq], 0, 0, 0); } }
            bf16x8 P[2];
#pragma unroll
            for (int gq = 0; gq < 2; ++gq) {
                float pv[8];
#pragma unroll
                for (int j = 0; j < 4; ++j) { pv[j] = __builtin_amdgcn_exp2f(sa[gq][j]); pv[4 + j] = __builtin_amdgcn_exp2f(sb[gq][j]); }
                if (OWN) {
#pragma unroll
                    for (int j = 0; j < 8; ++j) { const int kpos = n * 256 + kg * 32 + q4 * 8 + j; if (kpos > qrow[gq]) pv[j] = 0.f; }
                }
#pragma unroll
                for (int j = 0; j < 8; ++j) lsum[gq] += pv[j];
                u32x4 pk; pk.x = cvt_pk_bf16(pv[0], pv[1]); pk.y = cvt_pk_bf16(pv[2], pv[3]); pk.z = cvt_pk_bf16(pv[4], pv[5]); pk.w = cvt_pk_bf16(pv[6], pv[7]);
                P[gq] = __builtin_bit_cast(bf16x8, pk);
            }
#pragma unroll
            for (int dt = 0; dt < 8; ++dt) { const bf16x8 Vf = *(const bf16x8*)(Vl + (dt * 16 + qc) * 528 + (kg * 32 + q4 * 8) * 2);
#pragma unroll
                for (int gq = 0; gq < 2; ++gq) o[gq][dt] = __builtin_amdgcn_mfma_f32_16x16x32_bf16(Vf, P[gq], o[gq][dt], 0, 0, 0); }
        }
        if (has_next) {
#pragma unroll
            for (int gq = 0; gq < 2; ++gq) { const int qr = OWN ? nxt.tile * 256 + r0 + 16 * gq : (int)((enext[gq] & 0x7fffffffu) >> 2);
#pragma unroll
                for (int ks = 0; ks < 4; ++ks) Qf[gq][ks] = *(const bf16x8*)(QN + ((size_t)nxt.h * S + qr) * 128 + ks * 32 + q4 * 8); }
        }
#pragma unroll
        for (int gq = 0; gq < 2; ++gq) {
            float ls = lsum[gq]; ls += __shfl_xor(ls, 16); ls += __shfl_xor(ls, 32);
            const int qr = qrow[gq];
            if (OWN) {
                const int own = n, ns = own < 3 ? own : 3;
                for (int s = 0; s < ns; ++s) { ls += LPART[((size_t)qr * 8 + h) * 3 + s];
#pragma unroll
                    for (int dt = 0; dt < 8; ++dt) { const u32x2 v = __builtin_nontemporal_load((const u32x2*)(OPART + (((size_t)qr * 3 + s) * 8 + h) * 128 + dt * 16 + q4 * 4)); o[gq][dt][0] += bf_lo(v.x); o[gq][dt][1] += bf_hi(v.x); o[gq][dt][2] += bf_lo(v.y); o[gq][dt][3] += bf_hi(v.y); } }
                const float inv = 1.f / ls;
#pragma unroll
                for (int dt = 0; dt < 8; ++dt) { u32x2 v; v.x = cvt_pk_bf16(o[gq][dt][0] * inv, o[gq][dt][1] * inv); v.y = cvt_pk_bf16(o[gq][dt][2] * inv, o[gq][dt][3] * inv); *(u32x2*)(OPART + (((size_t)qr * 3) * 8 + h) * 128 + dt * 16 + q4 * 4) = v; }
            } else if ((ecur[gq] >> 31) != 0u) {
                const int slot = (int)(ecur[gq] & 3u);
#pragma unroll
                for (int dt = 0; dt < 8; ++dt) { u32x2 v; v.x = cvt_pk_bf16(o[gq][dt][0] * 1.f, o[gq][dt][1] * 1.f); v.y = cvt_pk_bf16(o[gq][dt][2] * 1.f, o[gq][dt][3] * 1.f); *(u32x2*)(OPART + (((size_t)qr * 3 + slot) * 8 + h) * 128 + dt * 16 + q4 * 4) = v; }
                if (q4 == 0) LPART[((size_t)qr * 8 + h) * 3 + slot] = ls;
            }
        }
        if (!has_next) break;
        it = itn; cur = nxt;
#pragma unroll
        for (int gq = 0; gq < 2; ++gq) { ecur[gq] = enext[gq]; enext[gq] = enn[gq]; }
    }
}

#define XB_TMO      128
#define XB_XCNT(j)  (256  + 64 * (j))
#define XB_XSUB(j)  (1280 + 64 * (j))
#define XB_XGEN(j)  (2304 + 64 * (j))
#define XB_TOP      3328
#define XB_TOPGEN   3392
#define XCD_BAR_WORDS 3456
#define XB_SPIN_CAP (1u << 18)
__device__ __forceinline__ unsigned xb_ld(unsigned* p)              { return __hip_atomic_load(p, __ATOMIC_RELAXED, __HIP_MEMORY_SCOPE_AGENT); }
__device__ __forceinline__ unsigned xb_add(unsigned* p, unsigned v) { return __hip_atomic_fetch_add(p, v, __ATOMIC_RELAXED, __HIP_MEMORY_SCOPE_AGENT); }
__device__ __forceinline__ unsigned xb_xcc_id() { return (unsigned)__builtin_amdgcn_s_getreg((3 << 11) | 20) & 0xFu; }
#define XB_SPIN(cond, bar) do { unsigned _sp = 0; while (cond) { __builtin_amdgcn_s_sleep(1); \
    if ((++_sp & 255u) == 0u) { if (xb_ld(&(bar)[XB_TMO])) break; if (_sp > XB_SPIN_CAP) { atomicAdd(&(bar)[XB_TMO], 1u); break; } } } } while (0)
struct XcdBarrier { unsigned* bar; unsigned x; volatile LAS unsigned* st; };
__device__ __forceinline__ void xcd_barrier_post(unsigned* bar) { if (threadIdx.x == 0) (void)xb_add(&bar[XB_XCNT(xb_xcc_id())], 1u); }
__device__ __forceinline__ void xcd_barrier_complete(unsigned* bar, unsigned x, unsigned& nloc, unsigned& nx) {
    const unsigned G = gridDim.x * gridDim.y * gridDim.z;
    unsigned sum, cnt, mine, sp = 0u;
    for (;;) {
        sum = 0u; cnt = 0u; mine = 0u;
#pragma unroll
        for (unsigned j = 0; j < 16; ++j) { const unsigned c = xb_ld(&bar[XB_XCNT(j)]); sum += c; cnt += (c > 0u) ? 1u : 0u; mine = (j == x) ? c : mine; }
        if (sum == G) break;
        __builtin_amdgcn_s_sleep(1);
        if ((++sp & 255u) == 0u) { if (xb_ld(&bar[XB_TMO])) break; if (sp > XB_SPIN_CAP) { atomicAdd(&bar[XB_TMO], 1u); break; } }
    }
    nloc = mine > 0u ? mine : 1u; nx = cnt > 0u ? cnt : 1u;
}
__device__ __forceinline__ void xcd_barrier(unsigned* bar_, volatile LAS unsigned* st_) {
    asm volatile("s_waitcnt vmcnt(0)" ::: "memory");
    __syncthreads();
    if (threadIdx.x == 0) {
        unsigned* bar = bar_; XcdBarrier b; b.bar = bar_; b.x = xb_xcc_id(); b.st = st_;
        __builtin_amdgcn_s_waitcnt(0);
        unsigned nloc = b.st[0], nx = b.st[1];
        if (nloc == 0u) { xcd_barrier_complete(bar, b.x, nloc, nx); b.st[0] = nloc; b.st[1] = nx; }
        const unsigned old = xb_add(&bar[XB_XSUB(b.x)], 1u);
        const unsigned gen = old / nloc;
        if (old + 1u == (gen + 1u) * nloc) {
            __builtin_amdgcn_fence(__ATOMIC_RELEASE, "agent");
            asm volatile("s_waitcnt vmcnt(0)" ::: "memory");
            const unsigned og = xb_add(&bar[XB_TOP], 1u);
            const unsigned tg = og / nx;
            if (og + 1u == (tg + 1u) * nx) xb_add(&bar[XB_TOPGEN], 1u);
            else XB_SPIN(xb_ld(&bar[XB_TOPGEN]) == tg, bar);
            __builtin_amdgcn_fence(__ATOMIC_ACQUIRE, "agent");
            xb_add(&bar[XB_XGEN(b.x)], 1u);
            asm volatile("s_waitcnt vmcnt(0)" ::: "memory");
        } else {
            XB_SPIN(xb_ld(&bar[XB_XGEN(b.x)]) == gen, bar);
            __builtin_amdgcn_fence(__ATOMIC_ACQUIRE, "agent");
            asm volatile("s_waitcnt vmcnt(0)" ::: "memory");
        }
    }
    __syncthreads();
}

__global__ void __launch_bounds__(512, 2) mk_fwd(Params p_unused) {
    extern __shared__ __attribute__((aligned(16))) unsigned char shm[];
    cg::grid_group grid = cg::this_grid();
    volatile LAS unsigned* xst = (volatile LAS unsigned*)((LAS unsigned char*)shm + (LDS_BYTES - 16));
    if (threadIdx.x == 0) { xst[0] = 0u; xst[1] = 0u; }
    __syncthreads();
    { KP p0 = (KP)__builtin_amdgcn_kernarg_segment_ptr(); unsigned* bw = (unsigned*)(p0->ws + WS_BAR);
      if (blockIdx.x == 0) for (int i = threadIdx.x; i < XCD_BAR_WORDS; i += 512) bw[i] = 0u; }
    int rep = 0; (void)rep;
    for (int ph = 0; ph <= 20; ++ph) {
        KP p = (KP)__builtin_amdgcn_kernarg_segment_ptr(); asm volatile("" : "+s"(p));
        unsigned char* ws = p->ws;
        float* rowss = (float*)(ws + WS_SSP); bf16_t* HB = (bf16_t*)(ws + WS_HB);
        switch (ph) {
        case 0: phase_prep(p, shm); break;
        case 1: case 9: case 11: case 19: {
            const int f = ph == 1 ? 0 : (ph == 9 ? 1 : (ph == 11 ? 2 : 3));
            const size_t wo = f == 0 ? W0_GU0 : (f == 1 ? W0_GU1 : (f == 2 ? W1_GU0 : W1_GU1));
            pg8::Gemm g{HB, (const bf16_t*)(ws + wo), S, 2 * FF, DM, DM}; pg8::StaticOrder so; so.init(S, 2 * FF, gridDim.x, mybid());
            const int pm0 = rs_table_build(shm, rowss, 2 * FF);
            EpiGU e{(bf16_t*)(ws + WS_ACT), rowss, (const float*)(shm + RS_LDS_OFF), pm0};
            pg8::gemm_phase(( LAS unsigned char*)shm, g, so, e);
            if (ph != 19) {
                const int stage = ph == 1 ? 1 : (ph == 9 ? 2 : 3); const int c = mybid(), wv = mytid() >> 6;
                if (gridDim.x == 256) { if (c >= 128) prep_weights(p, shm, stage, (c - 128) * 8 + wv, 1024); }
                else prep_weights(p, shm, stage, c * 8 + wv, gridDim.x * 8);
            } } break;
        case 2: case 10: case 12: case 20: case 8: case 18: {
            const bf16_t* A; const bf16_t* Bt; int K, lda; float w = 0.5f; int so_i;
            if (ph == 2) { A = (const bf16_t*)(ws + WS_ACT); Bt = (const bf16_t*)(ws + W0_D0); K = FF; lda = FF; so_i = 1; }
            else if (ph == 10) { A = (const bf16_t*)(ws + WS_ACT); Bt = (const bf16_t*)(ws + W0_D1); K = FF; lda = FF; so_i = 3; }
            else if (ph == 12) { A = (const bf16_t*)(ws + WS_ACT); Bt = (const bf16_t*)(ws + W1_D0); K = FF; lda = FF; so_i = 4; }
            else if (ph == 20) { A = (const bf16_t*)(ws + WS_ACT); Bt = (const bf16_t*)(ws + W1_D1); K = FF; lda = FF; so_i = -1; }
            else if (ph == 8) { A = (const bf16_t*)(ws + WS_U); Bt = (const bf16_t*)(ws + W0_OUT); K = DM; lda = DM; w = 1.f; so_i = 2; }
            else { A = (const bf16_t*)(ws + WS_OPART); Bt = (const bf16_t*)(ws + W1_MO); K = DM; lda = 3 * DM; w = 1.f; so_i = 5; }
            pg8::Gemm g{A, Bt, S, DM, K, lda}; pg8::StaticOrder so; so.init(S, DM, gridDim.x, mybid());
            EpiRes e{so_i >= 0 ? nullptr : p->out, HB, rowss, w};
            pg8::gemm_phase((LAS unsigned char*)shm, g, so, e); } break;
        case 3: { pg8::Gemm g{HB, (const bf16_t*)(ws + W0_IN), S, DM, DM, DM}; pg8::StaticOrder so; so.init(S, DM, gridDim.x, mybid());
            const int pm0 = rs_table_build(shm, rowss, DM);
            EpiU e{(bf16_t*)(ws + WS_U), rowss, (const float*)(shm + RS_LDS_OFF), pm0}; pg8::gemm_phase((LAS unsigned char*)shm, g, so, e); } break;
        case 4: phase_s5_scan<false>(p, shm); break;
        case 5: phase_s5_carry(p, shm); break;
        case 6: phase_s5_scan<true>(p, shm); break;
        case 7: { pg8::Gemm g{(const bf16_t*)(ws + WS_G), (const bf16_t*)(ws + W0_GLU), S, DM, DM, DM}; pg8::StaticOrder so; so.init(S, DM, gridDim.x, mybid());
            EpiGLU e{(const bf16_t*)(ws + WS_G), (bf16_t*)(ws + WS_U)}; pg8::gemm_phase((LAS unsigned char*)shm, g, so, e); } break;
        case 13: { pg8::Gemm g{HB, (const bf16_t*)(ws + W1_QKV), S, 3 * DM, DM, DM}; pg8::StaticOrder so; so.init(S, 3 * DM, gridDim.x, mybid());
            const int pm0 = rs_table_build(shm, rowss, 3 * DM);
            EpiQKV e{ws, rowss, (const float*)(shm + RS_LDS_OFF), pm0}; pg8::gemm_phase((LAS unsigned char*)shm, g, so, e); } break;
        case 14: phase_qknorm(p, shm); break;
        case 15: phase_gate(p, shm); break;
        case 16: phase_attn<false>(p, shm); break;
        case 17: phase_attn<true>(p, shm); break;
        }
        if (ph == 0) { grid.sync(); xcd_barrier_post((unsigned*)(ws + WS_BAR)); } else if (ph < 20) xcd_barrier((unsigned*)(ws + WS_BAR), xst);
#ifdef PROBE_PH
        if (ph == PROBE_PH && rep < PROBE_N) { ++rep; --ph; }
#endif
#ifdef PROBE_SYNC
        if (ph == 0) for (int k = 0; k < PROBE_SYNC; ++k) xcd_barrier((unsigned*)(ws + WS_BAR), xst);
#endif
    }
}

extern "C" void kernel_launch(void* const* d_in, const int* in_sizes, int n_in, void* d_out, int out_size, void* d_ws, size_t ws_size, hipStream_t stream) {
    static int grid_blocks = 0;
    if (!grid_blocks) {
        int dev = 0, cus = 0, per_cu = 0;
        (void)hipGetDevice(&dev);
        (void)hipDeviceGetAttribute(&cus, hipDeviceAttributeMultiprocessorCount, dev);
        (void)hipFuncSetAttribute((const void*)mk_fwd, hipFuncAttributeMaxDynamicSharedMemorySize, LDS_BYTES);
        (void)hipOccupancyMaxActiveBlocksPerMultiprocessor(&per_cu, (const void*)mk_fwd, 512, LDS_BYTES);
        if (per_cu < 1) per_cu = 1;
        grid_blocks = cus * per_cu;
        grid_blocks -= grid_blocks % 8;
        if (ws_size < 254 * MiB) fprintf(stderr, "kernel_launch: workspace too small: %zu\n", ws_size);
    }
    Params p{};
    const float** pp = (const float**)&p;
    for (int i = 0; i < 21; ++i) pp[i] = (const float*)d_in[i];
    p.out = (float*)d_out; p.ws = (unsigned char*)d_ws;
    for (int k = 0; k < 16; ++k) p.invf[k] = (float)pow(500000.0, -(double)k / 16.0);
    void* args[] = {&p};
    hipError_t e = hipLaunchCooperativeKernel((const void*)mk_fwd, dim3(grid_blocks), dim3(512), args, LDS_BYTES, stream);
    if (e != hipSuccess) fprintf(stderr, "cooperative launch failed: %s (grid %d)\n", hipGetErrorString(e), grid_blocks);
}
```

```cpp
#include <hip/hip_runtime.h>
#include <hip/hip_cooperative_groups.h>
#include <cstdio>
#include <cmath>
namespace cg = cooperative_groups;

#define LAS __attribute__((address_space(3)))
typedef unsigned short bf16_t;
typedef short bf16x8 __attribute__((ext_vector_type(8)));
typedef float f32x4 __attribute__((ext_vector_type(4)));
typedef float f32x16 __attribute__((ext_vector_type(16)));
typedef unsigned u32x4 __attribute__((ext_vector_type(4)));
typedef unsigned u32x2 __attribute__((ext_vector_type(2)));

constexpr int S = 16384, DM = 1024, FF = 2816, NH = 8;
constexpr float EPS = 1e-6f;
constexpr size_t MiB = 1048576;
constexpr size_t SZ_GU = (size_t)2 * FF * DM * 2, SZ_D = (size_t)DM * FF * 2, SZ_SQ = (size_t)DM * DM * 2, SZ_QKV = (size_t)3 * DM * DM * 2;
constexpr size_t W1_GU0 = 0, W1_D0 = W1_GU0 + SZ_GU, W1_QKV = W1_D0 + SZ_D, W1_MO = W1_QKV + SZ_QKV, W1_GU1 = W1_MO + SZ_SQ, W1_D1 = W1_GU1 + SZ_GU;
constexpr size_t WS_HB = 41 * MiB;
constexpr size_t WS_SMALL = 73 * MiB;
constexpr size_t WS_KMEAN = WS_SMALL;
constexpr size_t WS_CNT = WS_SMALL + 256 * 1024;
constexpr size_t WS_MSH = WS_CNT + 4096;
constexpr size_t WS_LPART = WS_SMALL + 512 * 1024;
constexpr size_t WS_BAR = WS_SMALL + 300 * 1024;
constexpr size_t WS_SSP = WS_SMALL + 2 * MiB;
constexpr size_t W0_GU0 = 76 * MiB, W0_D0 = W0_GU0 + SZ_GU, W0_IN = W0_D0 + SZ_D, W0_GLU = W0_IN + SZ_SQ, W0_OUT = W0_GLU + SZ_SQ, W0_GU1 = W0_OUT + SZ_SQ, W0_D1 = W0_GU1 + SZ_GU;
constexpr size_t WS_ACT = 115 * MiB;
constexpr size_t WS_U = 115 * MiB, WS_G = 147 * MiB, WS_EEND = 179 * MiB, WS_CARRY = 187 * MiB;
constexpr size_t WS_KN = 76 * MiB, WS_VT = 108 * MiB, WS_OPART = 140 * MiB, WS_QRAW = 140 * MiB, WS_VRAW = 172 * MiB, WS_LISTS = 236 * MiB;
constexpr size_t WS_QN = WS_HB;
constexpr size_t WS_ROPE = 252 * MiB;
constexpr int LDS_BYTES = 140 * 1024;

struct Params {
    const float *x, *ffn_norm, *w_gate, *w_up, *w_down, *mix_norm, *s5_w_in, *a_re, *a_im, *log_dt, *b_re, *b_im, *c_re, *c_im, *s5_d, *w_glu, *s5_w_out,
        *w_qkv, *q_gain, *k_gain, *mo_w_out;
    float* out; unsigned char* ws;
    float invf[16];
};

typedef const Params __attribute__((address_space(4)))* KP;
__device__ __forceinline__ int mytid() { int t = threadIdx.x; asm volatile("" : "+v"(t)); return t; }
__device__ __forceinline__ int mybid() { int b = blockIdx.x; asm volatile("" : "+s"(b)); return b; }
__device__ __forceinline__ unsigned cvt_pk_bf16(float lo, float hi) { unsigned r; asm volatile("v_cvt_pk_bf16_f32 %0, %1, %2" : "=v"(r) : "v"(lo), "v"(hi)); return r; }
__device__ __forceinline__ float bf_lo(unsigned v) { return __uint_as_float(v << 16); }
__device__ __forceinline__ float bf_hi(unsigned v) { return __uint_as_float(v & 0xffff0000u); }
__device__ __forceinline__ float wave_sum(float v) {
#pragma unroll
    for (int o = 1; o < 64; o <<= 1) v += __shfl_xor(v, o);
    return v;
}
__device__ __forceinline__ float fast_rcp(float x) { return __builtin_amdgcn_rcpf(x); }
__device__ __forceinline__ float sigmoidf_(float x) { return fast_rcp(1.f + __expf(-x)); }
__device__ __forceinline__ float gelu_tanh(float x) {
    const float z = 0.7978845608028654f * (x + 0.044715f * x * x * x);
    const float t = 1.f - 2.f * fast_rcp(__expf(2.f * z) + 1.f);
    return 0.5f * x * (1.f + t);
}

namespace pg8 {
constexpr int BM = 256, BK = 64, HALF = 128, HTB = HALF * BK * 2, STAGE_BYTES = 8 * HTB, NXCD = 8, WGM = 8;
__host__ __device__ __forceinline__ int lds_byte(int r, int c) { const int st = (r >> 4) * 2 + (c >> 5), rr = r & 15, cc = c & 31, ob = rr * 64 + cc * 2; return st * 1024 + (ob ^ (((ob >> 9) & 1) << 5)); }
__host__ __device__ __forceinline__ void stage_rc(int b, int& R, int& C) { const int st = b / 1024, sb = b % 1024, swz = sb ^ (((sb >> 9) & 1) << 5); R = (st >> 1) * 16 + swz / 64; C = (st & 1) * 32 + (swz % 64) / 2; }
__host__ __device__ __forceinline__ int perm32(int rho) { const int n = rho >> 4, i = rho & 15; return 8 * (i >> 2) + 4 * n + (i & 3); }
struct Unit { int pm, pn; };
struct Gemm { const bf16_t* A; const bf16_t* Bt; int M, N, K, lda; };
struct StaticOrder {
    int nM, nN, nwg, G, c;
    __device__ void init(int M, int N, int G_, int c_) { nM = M / BM; nN = N / BM; nwg = nM * nN; G = G_; c = c_; }
    __device__ bool next(int i, Unit& u) const {
        const long L = (long)i * G + c; if (L >= nwg) return false;
        int wgid = (int)L; { const int q = nwg / NXCD, r = nwg % NXCD, xcd = wgid % NXCD, off = wgid / NXCD; wgid = (xcd < r ? xcd * (q + 1) : r * (q + 1) + (xcd - r) * q) + off; }
        const int nig = WGM * nN, gid = wgid / nig, fm = gid * WGM, gsz = (nM - fm) < WGM ? (nM - fm) : WGM;
        u.pm = fm + ((wgid % nig) % gsz); u.pn = (wgid % nig) / gsz; return true;
    }
};
template <class Epi>
__device__ __forceinline__ void gemm_phase(LAS unsigned char* lds, const Gemm g, const StaticOrder& S_, const Epi& E) {
    const int tid = mytid(), wid = __builtin_amdgcn_readfirstlane(tid >> 6), lane = tid & 63, wr = wid >> 2, wc = wid & 3, fr = lane & 15, fq = lane >> 4;
    const int K = g.K, nt = K / BK, lda = g.lda;
    unsigned voffA[2], voffB[2];
#pragma unroll
    for (int i = 0; i < 2; ++i) { int R, C; stage_rc(tid * 16 + i * 8192, R, C); const int Rb = Epi::PERM ? ((R & ~31) + perm32(R & 31)) : R;
        voffA[i] = (unsigned)(R * lda + C) * 2u; voffB[i] = (unsigned)(Rb * K + C) * 2u; }
    const size_t kstep = (size_t)(BK * 2);
    const size_t hstepA = (size_t)HALF * lda * 2, hstepB = (size_t)HALF * K * 2;
    const size_t tstepA = 2 * hstepA, tstepB = 2 * hstepB;
    const unsigned ldsw = (unsigned)wid * 1024u;
    const int aoff = lds_byte(wr * 64 + fr, fq * 8), boff = lds_byte(wc * 32 + fr, fq * 8);
#define PG8_SA(b, h) (((b) * 2 + (h)) * HTB)
#define PG8_SB(b, h) ((4 + (b) * 2 + (h)) * HTB)
#define PG8_STAGE(bufoff, gbase, voff) do { _Pragma("unroll") for (int _i = 0; _i < 2; ++_i) \
        __builtin_amdgcn_global_load_lds((const unsigned*)((const char*)(gbase) + (voff)[_i]), (LAS unsigned*)(lds + (bufoff) + ldsw + _i * 8192), 16, 0, 0); } while (0)
#define PG8_LDA(dst, b, h) do { _Pragma("unroll") for (int m = 0; m < 4; ++m) _Pragma("unroll") for (int k = 0; k < 2; ++k) dst[m][k] = *(const LAS bf16x8*)(lds + PG8_SA(b, h) + aoff + m * 2048 + k * 1024); } while (0)
#define PG8_LDB(dst, b, h) do { _Pragma("unroll") for (int n = 0; n < 2; ++n) _Pragma("unroll") for (int k = 0; k < 2; ++k) dst[n][k] = *(const LAS bf16x8*)(lds + PG8_SB(b, h) + boff + n * 2048 + k * 1024); } while (0)
#define PG8_MMA(ai, bj, At, Bt) do { __builtin_amdgcn_s_setprio(1); _Pragma("unroll") for (int m = 0; m < 4; ++m) _Pragma("unroll") for (int n = 0; n < 2; ++n) _Pragma("unroll") for (int k = 0; k < 2; ++k) \
        acc[ai][bj][m][n] = __builtin_amdgcn_mfma_f32_16x16x32_bf16(Bt[n][k], At[m][k], acc[ai][bj][m][n], 0, 0, 0); __builtin_amdgcn_s_setprio(0); } while (0)
#define PG8_WAIT_V(n) asm volatile("s_waitcnt vmcnt(" #n ")" ::: "memory")
#define PG8_WAIT_L(n) asm volatile("s_waitcnt lgkmcnt(" #n ")" ::: "memory")
#define PG8_BAR __builtin_amdgcn_s_barrier()
#define PG8_SCHED __builtin_amdgcn_sched_barrier(0)
    Unit cur, nxt; int ui = 0;
    if (!S_.next(0, cur)) return;
    f32x4 acc[2][2][4][2];
#pragma unroll
    for (int a = 0; a < 2; ++a)
#pragma unroll
        for (int b = 0; b < 2; ++b)
#pragma unroll
            for (int m = 0; m < 4; ++m)
#pragma unroll
                for (int n = 0; n < 2; ++n) acc[a][b][m][n] = (f32x4){0.f, 0.f, 0.f, 0.f};
    bf16x8 At[4][2], B0[2][2], B1[2][2];
    const char* cA = (const char*)g.A + (size_t)cur.pm * tstepA; const char* cB = (const char*)g.Bt + (size_t)cur.pn * tstepB;
    typename Epi::IR ir;
    if constexpr (Epi::HAS_INIT) E.init_issue(ir, cur, wr, wc, fr, fq);
    PG8_STAGE(PG8_SB(0, 0), cB, voffB); PG8_STAGE(PG8_SA(0, 0), cA, voffA); PG8_STAGE(PG8_SB(0, 1), cB + hstepB, voffB); PG8_STAGE(PG8_SA(0, 1), cA + hstepA, voffA);
    if (wr == 1) PG8_BAR;
    PG8_WAIT_V(4); PG8_BAR;
    PG8_STAGE(PG8_SB(1, 0), cB + kstep, voffB); PG8_STAGE(PG8_SA(1, 0), cA + kstep, voffA); PG8_STAGE(PG8_SB(1, 1), cB + hstepB + kstep, voffB);
    PG8_WAIT_V(6); PG8_BAR;
    if constexpr (Epi::HAS_INIT) E.init_finish(acc, ir);
    for (;;) {
        const bool has_next = S_.next(ui + 1, nxt);
        const char* nA = has_next ? (const char*)g.A + (size_t)nxt.pm * tstepA : cA; const char* nB = has_next ? (const char*)g.Bt + (size_t)nxt.pn * tstepB : cB;
        for (int t = 0; t < nt; t += 2) {
            const bool last = (t == nt - 2);
            const char* a1 = cA + (size_t)(t + 1) * kstep;
            const char* a2 = last ? nA : cA + (size_t)(t + 2) * kstep; const char* b2 = last ? nB : cB + (size_t)(t + 2) * kstep;
            const char* a3 = a2 + kstep; const char* b3 = b2 + kstep;
            PG8_LDB(B0, 0, 0); PG8_SCHED; PG8_LDA(At, 0, 0); PG8_STAGE(PG8_SA(1, 1), a1 + hstepA, voffA);
            PG8_WAIT_L(8); PG8_BAR; PG8_WAIT_L(0); PG8_MMA(0, 0, At, B0); PG8_BAR; PG8_SCHED;
            PG8_LDB(B1, 0, 1); PG8_STAGE(PG8_SB(0, 0), b2, voffB);
            PG8_BAR; PG8_WAIT_L(0); PG8_MMA(0, 1, At, B1); PG8_BAR;
            PG8_LDA(At, 0, 1); PG8_STAGE(PG8_SA(0, 0), a2, voffA);
            PG8_BAR; PG8_WAIT_L(0); PG8_MMA(1, 0, At, B0); PG8_BAR; PG8_SCHED;
            PG8_STAGE(PG8_SB(0, 1), b2 + hstepB, voffB);
            PG8_WAIT_V(6); PG8_BAR; PG8_MMA(1, 1, At, B1); PG8_BAR;
            PG8_LDB(B0, 1, 0); PG8_SCHED; PG8_LDA(At, 1, 0); PG8_STAGE(PG8_SA(0, 1), a2 + hstepA, voffA);
            PG8_WAIT_L(8); PG8_BAR; PG8_WAIT_L(0); PG8_MMA(0, 0, At, B0); PG8_BAR; PG8_SCHED;
            PG8_LDB(B1, 1, 1); PG8_STAGE(PG8_SB(1, 0), b3, voffB);
            PG8_BAR; PG8_WAIT_L(0); PG8_MMA(0, 1, At, B1); PG8_BAR;
            PG8_LDA(At, 1, 1); PG8_STAGE(PG8_SA(1, 0), a3, voffA);
            PG8_BAR; PG8_WAIT_L(0); PG8_MMA(1, 0, At, B0); PG8_BAR; PG8_SCHED;
            PG8_STAGE(PG8_SB(1, 1), b3 + hstepB, voffB);
            PG8_WAIT_V(6); PG8_BAR; PG8_MMA(1, 1, At, B1); PG8_BAR;
        }
        E(acc, cur, wr, wc, fr, fq);
        if (!has_next) break;
#pragma unroll
        for (int a = 0; a < 2; ++a)
#pragma unroll
            for (int b = 0; b < 2; ++b)
#pragma unroll
                for (int m = 0; m < 4; ++m)
#pragma unroll
                    for (int n = 0; n < 2; ++n) acc[a][b][m][n] = (f32x4){0.f, 0.f, 0.f, 0.f};
        if constexpr (Epi::HAS_INIT) { E.init_issue(ir, nxt, wr, wc, fr, fq); E.init_finish(acc, ir); }
        cur = nxt; cA = nA; cB = nB; ++ui;
    }
    PG8_WAIT_V(0);
    if (wr == 0) PG8_BAR;
    PG8_BAR;
#undef PG8_SA
#undef PG8_SB
#undef PG8_STAGE
#undef PG8_LDA
#undef PG8_LDB
#undef PG8_MMA
#undef PG8_WAIT_V
#undef PG8_WAIT_L
#undef PG8_BAR
#undef PG8_SCHED
}
}
using pg8::Unit;
typedef const f32x4 (&AccRef)[2][2][4][2];
typedef f32x4 (&AccMut)[2][2][4][2];

__device__ __forceinline__ void st16_wt(void* base, int bytes, unsigned off, u32x4 v) { __builtin_amdgcn_raw_buffer_store_b128(v, __builtin_amdgcn_make_buffer_rsrc(base, (short)0, bytes, 0x00020000), off, 0, 16); }
__device__ __forceinline__ void st8_wt(void* base, int bytes, unsigned off, u32x2 v) { __builtin_amdgcn_raw_buffer_store_b64(v, __builtin_amdgcn_make_buffer_rsrc(base, (short)0, bytes, 0x00020000), off, 0, 16); }
__device__ __forceinline__ float row_rstd(const float* ssp, int r) {
    const f32x4* q = (const f32x4*)(ssp + (size_t)r * 16); const f32x4 a = q[0], b = q[1], c = q[2], d = q[3];
    const float s = ((a[0] + a[1]) + (a[2] + a[3])) + ((b[0] + b[1]) + (b[2] + b[3])) + ((c[0] + c[1]) + (c[2] + c[3])) + ((d[0] + d[1]) + (d[2] + d[3]));
    return rsqrtf(s * (1.f / DM) + EPS);
}
constexpr int RS_LDS_OFF = 131072;
__device__ __forceinline__ int rs_table_build(unsigned char* shm, const float* ssp, int N) {
    pg8::StaticOrder so; so.init(S, N, gridDim.x, mybid()); pg8::Unit u0; int pm0 = -1;
    if (so.next(0, u0)) pm0 = u0.pm;
    const int t = mytid();
    if (pm0 >= 0 && t < 256) ((float*)(shm + RS_LDS_OFF))[t] = row_rstd(ssp, pm0 * 256 + t);
    __syncthreads();
    return pm0;
}
__device__ __forceinline__ float rs_get(const float* rsl, int pm0, const float* ssp, int pm, int r) { return pm == pm0 ? rsl[r - pm0 * 256] : row_rstd(ssp, r); }
struct EpiGU {
    static constexpr bool PERM = true, HAS_INIT = false; struct IR {};
    bf16_t* act; const float* ss; const float* rsl; int pm0;
    __device__ __forceinline__ void operator()(AccRef acc, const Unit& u, int wr, int wc, int fr, int fq) const {
        const int row0 = u.pm * 256 + wr * 64 + fr, col0 = u.pn * 128 + wc * 32 + 8 * fq;
#pragma unroll
        for (int ai = 0; ai < 2; ++ai)
#pragma unroll
            for (int m = 0; m < 4; ++m) {
                const int r = row0 + ai * 128 + m * 16; const float rs = rs_get(rsl, pm0, ss, u.pm, r);
                float v[8];
#pragma unroll
                for (int n = 0; n < 2; ++n)
#pragma unroll
                    for (int i = 0; i < 4; ++i) { const float gt = acc[ai][0][m][n][i] * rs, up = acc[ai][1][m][n][i] * rs; v[n * 4 + i] = gt * sigmoidf_(gt) * up; }
                u32x4 o; o.x = cvt_pk_bf16(v[0], v[1]); o.y = cvt_pk_bf16(v[2], v[3]); o.z = cvt_pk_bf16(v[4], v[5]); o.w = cvt_pk_bf16(v[6], v[7]);
                st16_wt(act, S * FF * 2, (unsigned)(r * FF + col0) * 2u, o);
            }
    }
};
struct EpiRes {
    static constexpr bool PERM = false, HAS_INIT = true;
    float* fout; bf16_t* hb; float* ss; float w;
    struct IR { u32x2 v[2][4][2][2]; };
    __device__ __forceinline__ void init_issue(IR& ir, const Unit& u, int wr, int wc, int fr, int fq) const {
        const int row0 = u.pm * 256 + wr * 64 + fr, col0 = u.pn * 256 + wc * 32 + 4 * fq;
#pragma unroll
        for (int ai = 0; ai < 2; ++ai)
#pragma unroll
            for (int m = 0; m < 4; ++m)
#pragma unroll
                for (int bj = 0; bj < 2; ++bj)
#pragma unroll
                    for (int n = 0; n < 2; ++n) ir.v[ai][m][bj][n] = *(const u32x2*)(hb + (size_t)(row0 + ai * 128 + m * 16) * DM + col0 + bj * 128 + n * 16);
    }
    __device__ __forceinline__ void init_finish(AccMut acc, const IR& ir) const {
        const float iw = 1.f / w;
#pragma unroll
        for (int ai = 0; ai < 2; ++ai)
#pragma unroll
            for (int m = 0; m < 4; ++m)
#pragma unroll
                for (int bj = 0; bj < 2; ++bj)
#pragma unroll
                    for (int n = 0; n < 2; ++n) { const u32x2 v = ir.v[ai][m][bj][n]; acc[ai][bj][m][n] = (f32x4){bf_lo(v.x) * iw, bf_hi(v.x) * iw, bf_lo(v.y) * iw, bf_hi(v.y) * iw}; }
    }
    __device__ __forceinline__ void operator()(AccRef acc, const Unit& u, int wr, int wc, int fr, int fq) const {
        const int row0 = u.pm * 256 + wr * 64 + fr, col0 = u.pn * 256 + wc * 32 + 4 * fq;
#pragma unroll
        for (int ai = 0; ai < 2; ++ai) {
#pragma unroll
            for (int m = 0; m < 4; ++m) {
                const int r = row0 + ai * 128 + m * 16; float sq = 0.f;
#pragma unroll
                for (int bj = 0; bj < 2; ++bj)
#pragma unroll
                    for (int n = 0; n < 2; ++n) {
                        const size_t idx = (size_t)r * DM + col0 + bj * 128 + n * 16;
                        const f32x4 h = acc[ai][bj][m][n] * w;
                        if (fout) st16_wt(fout, S * DM * 4, (unsigned)idx * 4u, __builtin_bit_cast(u32x4, h));
                        else { u32x2 o; o.x = cvt_pk_bf16(h[0], h[1]); o.y = cvt_pk_bf16(h[2], h[3]); st8_wt(hb, S * DM * 2, (unsigned)idx * 2u, o); }
                        sq += h[0] * h[0] + h[1] * h[1] + h[2] * h[2] + h[3] * h[3];
                    }
                if (!fout) { sq += __shfl_xor(sq, 16); sq += __shfl_xor(sq, 32); if (fq == 0) ss[(size_t)r * 16 + u.pn * 4 + wc] = sq; }
            }
        }
    }
};
struct EpiU {
    static constexpr bool PERM = true, HAS_INIT = false; struct IR {};
    bf16_t* o; const float* ss; const float* rsl; int pm0;
    __device__ __forceinline__ void operator()(AccRef acc, const Unit& u, int wr, int wc, int fr, int fq) const {
        const int row0 = u.pm * 256 + wr * 64 + fr, col0 = u.pn * 256 + wc * 32 + 8 * fq;
#pragma unroll
        for (int ai = 0; ai < 2; ++ai)
#pragma unroll
            for (int m = 0; m < 4; ++m) {
                const int r = row0 + ai * 128 + m * 16; const float rs = rs_get(rsl, pm0, ss, u.pm, r);
#pragma unroll
                for (int bj = 0; bj < 2; ++bj) { const f32x4 a = acc[ai][bj][m][0] * rs, b = acc[ai][bj][m][1] * rs;
                    u32x4 v; v.x = cvt_pk_bf16(a[0], a[1]); v.y = cvt_pk_bf16(a[2], a[3]); v.z = cvt_pk_bf16(b[0], b[1]); v.w = cvt_pk_bf16(b[2], b[3]);
                    st16_wt(o, S * DM * 2, (unsigned)(r * DM + col0 + bj * 128) * 2u, v); }
            }
    }
};
struct EpiGLU {
    static constexpr bool PERM = true, HAS_INIT = false; struct IR {};
    const bf16_t* g; bf16_t* o;
    __device__ __forceinline__ void operator()(AccRef acc, const Unit& u, int wr, int wc, int fr, int fq) const {
        const int row0 = u.pm * 256 + wr * 64 + fr, col0 = u.pn * 256 + wc * 32 + 8 * fq;
#pragma unroll
        for (int ai = 0; ai < 2; ++ai) {
            u32x4 gvv[4][2];
#pragma unroll
            for (int m = 0; m < 4; ++m)
#pragma unroll
                for (int bj = 0; bj < 2; ++bj) gvv[m][bj] = *(const u32x4*)(g + (size_t)(row0 + ai * 128 + m * 16) * DM + col0 + bj * 128);
#pragma unroll
            for (int m = 0; m < 4; ++m) {
                const int r = row0 + ai * 128 + m * 16;
#pragma unroll
                for (int bj = 0; bj < 2; ++bj) { const size_t idx = (size_t)r * DM + col0 + bj * 128; const u32x4 gv = gvv[m][bj];
                    const f32x4 a = acc[ai][bj][m][0], b = acc[ai][bj][m][1];
                    u32x4 v; v.x = cvt_pk_bf16(bf_lo(gv.x) * sigmoidf_(a[0]), bf_hi(gv.x) * sigmoidf_(a[1])); v.y = cvt_pk_bf16(bf_lo(gv.y) * sigmoidf_(a[2]), bf_hi(gv.y) * sigmoidf_(a[3]));
                    v.z = cvt_pk_bf16(bf_lo(gv.z) * sigmoidf_(b[0]), bf_hi(gv.z) * sigmoidf_(b[1])); v.w = cvt_pk_bf16(bf_lo(gv.w) * sigmoidf_(b[2]), bf_hi(gv.w) * sigmoidf_(b[3]));
                    st16_wt(o, S * DM * 2, (unsigned)idx * 2u, v); }
            }
        }
    }
};
struct EpiQKV {
    static constexpr bool PERM = true, HAS_INIT = false; struct IR {};
    unsigned char* ws; const float* ss; const float* rsl; int pm0;
    __device__ __forceinline__ void operator()(AccRef acc, const Unit& u, int wr, int wc, int fr, int fq) const {
        const int row0 = u.pm * 256 + wr * 64 + fr, t = u.pn >> 2; const size_t boff = t == 0 ? WS_QRAW : (t == 1 ? WS_KN : WS_VRAW); bf16_t* base = (bf16_t*)(ws + boff);
        const int d0 = wc * 32 + 8 * fq;
#pragma unroll
        for (int ai = 0; ai < 2; ++ai)
#pragma unroll
            for (int m = 0; m < 4; ++m) {
                const int r = row0 + ai * 128 + m * 16; const float rs = rs_get(rsl, pm0, ss, u.pm, r);
#pragma unroll
                for (int bj = 0; bj < 2; ++bj) { const int h = (u.pn & 3) * 2 + bj; const f32x4 a = acc[ai][bj][m][0] * rs, b = acc[ai][bj][m][1] * rs;
                    u32x4 vv; vv.x = cvt_pk_bf16(a[0], a[1]); vv.y = cvt_pk_bf16(a[2], a[3]); vv.z = cvt_pk_bf16(b[0], b[1]); vv.w = cvt_pk_bf16(b[2], b[3]);
                    st16_wt(base, S * DM * 2, (unsigned)((h * S + r) * 128 + d0) * 2u, vv); }
            }
    }
};

__device__ __forceinline__ void wave_lds_sync() { asm volatile("s_waitcnt lgkmcnt(0)" ::: "memory"); __builtin_amdgcn_wave_barrier(); }
__device__ __forceinline__ void p0_transpose_item(const float* W, int K, int N, bf16_t* WT, const float* sc, int gu, int roff, float* scr, int item, int lane) {
    const int nblk = N / 32, kb = item / nblk, nb = item % nblk, k0 = 64 * kb, n0 = 32 * nb;
    float wv[32];
#pragma unroll
    for (int i = 0; i < 32; ++i) wv[i] = __builtin_nontemporal_load(&W[(size_t)(k0 + 2 * i + (lane >> 5)) * N + n0 + (lane & 31)]);
#pragma unroll
    for (int i = 0; i < 32; ++i) { const int kk = 2 * i + (lane >> 5); float v = wv[i]; if (sc) v *= sc[k0 + kk]; scr[kk * 33 + (lane & 31)] = v; }
    wave_lds_sync();
    const int c = lane & 7;
#pragma unroll
    for (int j = 0; j < 4; ++j) { const int n = (lane >> 3) + 8 * j; const float* s = scr + (8 * c) * 33 + n;
        u32x4 o; o.x = cvt_pk_bf16(s[0 * 33], s[1 * 33]); o.y = cvt_pk_bf16(s[2 * 33], s[3 * 33]); o.z = cvt_pk_bf16(s[4 * 33], s[5 * 33]); o.w = cvt_pk_bf16(s[6 * 33], s[7 * 33]);
        const int nn = n0 + n; const int row = gu ? ((nn >> 7) * 256 + roff + (nn & 127)) : nn;
        *(u32x4*)(WT + (size_t)row * K + k0 + 8 * c) = o; }
    wave_lds_sync();
}
__device__ __forceinline__ void prep_weights(KP p, unsigned char* shm, int stage, int widx, int nw) {
    const int tid = mytid(), wave = tid >> 6, lane = tid & 63;
    float* scr = (float*)(shm + wave * 16384);
    unsigned char* ws = p->ws;
    constexpr int I_FF = (DM / 64) * (FF / 32), I_D = (FF / 64) * (DM / 32), I_SQ = (DM / 64) * (DM / 32), I_QKV = (DM / 64) * (3 * DM / 32);
    constexpr int F1 = 2 * I_FF + I_D, NITEMS = 4 * F1 + 4 * I_SQ + I_QKV;
    const int lo1 = stage == 0 ? 0 : (stage == 1 ? 2 * I_FF : (stage == 2 ? 2 * F1 : 3 * F1)), hi1 = stage == 0 ? 2 * I_FF : (stage == 1 ? 2 * F1 : (stage == 2 ? 3 * F1 : 4 * F1));
    const int lo2 = stage == 1 ? 4 * F1 : (stage == 2 ? 4 * F1 + 3 * I_SQ : 0), hi2 = stage == 1 ? 4 * F1 + 3 * I_SQ : (stage == 2 ? NITEMS : 0);
    const int n1 = hi1 - lo1, ntot = n1 + (hi2 - lo2);
    for (int v = widx; v < ntot; v += nw) {
        const int it = v < n1 ? lo1 + v : lo2 + (v - n1);
        int r = it;
        if (r < 4 * (2 * I_FF + I_D)) {
            const int f = r / (2 * I_FF + I_D); r -= f * (2 * I_FF + I_D);
            const size_t gu_off = f == 0 ? W0_GU0 : (f == 1 ? W0_GU1 : (f == 2 ? W1_GU0 : W1_GU1));
            const size_t d_off = f == 0 ? W0_D0 : (f == 1 ? W0_D1 : (f == 2 ? W1_D0 : W1_D1));
            if (r < I_FF) p0_transpose_item(p->w_gate + (size_t)f * DM * FF, DM, FF, (bf16_t*)(ws + gu_off), p->ffn_norm + f * DM, 1, 0, scr, r, lane);
            else if (r < 2 * I_FF) p0_transpose_item(p->w_up + (size_t)f * DM * FF, DM, FF, (bf16_t*)(ws + gu_off), p->ffn_norm + f * DM, 1, 128, scr, r - I_FF, lane);
            else p0_transpose_item(p->w_down + (size_t)f * DM * FF, FF, DM, (bf16_t*)(ws + d_off), nullptr, 0, 0, scr, r - 2 * I_FF, lane);
            continue;
        }
        r -= 4 * (2 * I_FF + I_D);
        if (r < I_SQ) { p0_transpose_item(p->s5_w_in, DM, DM, (bf16_t*)(ws + W0_IN), p->mix_norm, 0, 0, scr, r, lane); continue; } r -= I_SQ;
        if (r < I_SQ) { p0_transpose_item(p->w_glu, DM, DM, (bf16_t*)(ws + W0_GLU), nullptr, 0, 0, scr, r, lane); continue; } r -= I_SQ;
        if (r < I_SQ) { p0_transpose_item(p->s5_w_out, DM, DM, (bf16_t*)(ws + W0_OUT), nullptr, 0, 0, scr, r, lane); continue; } r -= I_SQ;
        if (r < I_SQ) { p0_transpose_item(p->mo_w_out, DM, DM, (bf16_t*)(ws + W1_MO), nullptr, 0, 0, scr, r, lane); continue; } r -= I_SQ;
        p0_transpose_item(p->w_qkv, DM, 3 * DM, (bf16_t*)(ws + W1_QKV), p->mix_norm + DM, 0, 0, scr, r, lane);
    }
    if (stage == 2) { float2* rope = (float2*)(ws + WS_ROPE);
        for (int i = widx * 64 + lane; i < S * 16; i += nw * 64) { const float ang = (float)(i >> 4) * p->invf[i & 15]; rope[i] = make_float2(cosf(ang), sinf(ang)); } }
}
__device__ __forceinline__ void phase_prep(KP p, unsigned char* shm) {
    const int tid = mytid(), wave = tid >> 6, lane = tid & 63;
    const int gw = mybid() * 8 + wave, NGW = gridDim.x * 8;
    unsigned char* ws = p->ws;
    prep_weights(p, shm, 0, gw, NGW);
    float* rowss = (float*)(ws + WS_SSP); bf16_t* hb = (bf16_t*)(ws + WS_HB);
    for (int row0 = gw * 4; row0 < S; row0 += NGW * 4) {
        f32x4 xv[4][4];
#pragma unroll
        for (int q = 0; q < 4; ++q)
#pragma unroll
            for (int j = 0; j < 4; ++j) xv[q][j] = __builtin_nontemporal_load(((const f32x4*)(p->x + (size_t)(row0 + q) * DM) + lane) + 64 * j);
#pragma unroll
        for (int q = 0; q < 4; ++q) { const int row = row0 + q; float s = 0.f;
#pragma unroll
            for (int j = 0; j < 4; ++j) { const f32x4 v = xv[q][j]; s += v[0] * v[0] + v[1] * v[1] + v[2] * v[2] + v[3] * v[3];
                u32x2 o; o.x = cvt_pk_bf16(v[0], v[1]); o.y = cvt_pk_bf16(v[2], v[3]); *((u32x2*)(hb + (size_t)row * DM) + lane + 64 * j) = o; }
            s = wave_sum(s); if (lane < 16) rowss[(size_t)row * 16 + lane] = lane == 0 ? s : 0.f; }
    }
    if (mybid() == 0) {
        ((int*)(ws + WS_CNT))[tid] = 0;
        if (wave == 0) { float a = fmaxf(fabsf(p->q_gain[lane]), fabsf(p->q_gain[lane + 64])), b = fmaxf(fabsf(p->k_gain[lane]), fabsf(p->k_gain[lane + 64]));
#pragma unroll
            for (int o = 1; o < 64; o <<= 1) { a = fmaxf(a, __shfl_xor(a, o)); b = fmaxf(b, __shfl_xor(b, o)); }
            if (lane == 0) *(float*)(ws + WS_MSH) = 16.322231146f * a * b;   }
    }
}

__device__ __forceinline__ void s5_lambda(KP p, int g, int P, float& lr, float& li, float& cr, float& ci) {
    const float dt = expf(p->log_dt[g]); const float are = p->a_re[g * 64 + P], aim = p->a_im[g * 64 + P];
    const float mag = expf(are * dt), ang = aim * dt; lr = mag * cosf(ang); li = mag * sinf(ang);
    const float den = are * are + aim * aim, nre = lr - 1.f; cr = (nre * are + li * aim) / den; ci = (li * are - nre * aim) / den;
}
template <bool MAIN>
__device__ __forceinline__ void phase_s5_scan(KP p, unsigned char* shm) {
    const int tid = mytid(), wave = tid >> 6, lane = tid & 63, half = lane >> 5, sc = lane & 31;
    unsigned char* wl = shm + wave * (32 * 272);
    const int gw = mybid() * 8 + wave, NGW = gridDim.x * 8;
    const bf16_t* U = (const bf16_t*)(p->ws + WS_U); bf16_t* G = (bf16_t*)(p->ws + WS_G);
    float2* EEND = (float2*)(p->ws + WS_EEND); const float2* CARRY = (const float2*)(p->ws + WS_CARRY);
    const int g = gw & 63;
    float lr[2], li[2], xr[2], xi[2]; bf16x8 Bre[2], Bim[2];
#pragma unroll
        for (int s = 0; s < 2; ++s) {
            const int P = sc + 32 * s; float cr, ci; s5_lambda(p, g, P, lr[s], li[s], cr, ci);
            const f32x4* br = (const f32x4*)(p->b_re + ((size_t)(g * 64 + P) * 16 + half * 8)); const f32x4* bi = (const f32x4*)(p->b_im + ((size_t)(g * 64 + P) * 16 + half * 8));
            const f32x4 r0 = br[0], r1 = br[1], i0 = bi[0], i1 = bi[1];
            u32x4 a, b;
            a.x = cvt_pk_bf16(cr * r0[0] - ci * i0[0], cr * r0[1] - ci * i0[1]); a.y = cvt_pk_bf16(cr * r0[2] - ci * i0[2], cr * r0[3] - ci * i0[3]);
            a.z = cvt_pk_bf16(cr * r1[0] - ci * i1[0], cr * r1[1] - ci * i1[1]); a.w = cvt_pk_bf16(cr * r1[2] - ci * i1[2], cr * r1[3] - ci * i1[3]);
            b.x = cvt_pk_bf16(cr * i0[0] + ci * r0[0], cr * i0[1] + ci * r0[1]); b.y = cvt_pk_bf16(cr * i0[2] + ci * r0[2], cr * i0[3] + ci * r0[3]);
            b.z = cvt_pk_bf16(cr * i1[0] + ci * r1[0], cr * i1[1] + ci * r1[1]); b.w = cvt_pk_bf16(cr * i1[2] + ci * r1[2], cr * i1[3] + ci * r1[3]);
            Bre[s] = __builtin_bit_cast(bf16x8, a); Bim[s] = __builtin_bit_cast(bf16x8, b);
        }
        bf16x8 Cm[4]; float dsk[4];
        if (MAIN) {
            const int ch = lane & 15, q8 = lane >> 4; const float* cre = p->c_re + (size_t)(g * 16 + ch) * 64; const float* cim = p->c_im + (size_t)(g * 16 + ch) * 64;
#pragma unroll
            for (int ks = 0; ks < 4; ++ks) { const int s0 = ks * 8 + q8 * 2; u32x4 v;
                v.x = cvt_pk_bf16(cre[s0], cre[s0 + 32]); v.y = cvt_pk_bf16(-cim[s0], -cim[s0 + 32]); v.z = cvt_pk_bf16(cre[s0 + 1], cre[s0 + 33]); v.w = cvt_pk_bf16(-cim[s0 + 1], -cim[s0 + 33]);
                Cm[ks] = __builtin_bit_cast(bf16x8, v); }
#pragma unroll
            for (int j = 0; j < 4; ++j) dsk[j] = p->s5_d[g * 16 + q8 * 4 + j];
        }
    for (int cp = gw >> 6; cp < 128; cp += NGW >> 6) {
#pragma unroll
        for (int s = 0; s < 2; ++s) { if (MAIN) { const float2 c = CARRY[(size_t)(2 * cp + half) * 4096 + g * 64 + sc + 32 * s]; xr[s] = c.x; xi[s] = c.y; } else { xr[s] = 0.f; xi[s] = 0.f; } }
        const int ar = lane & 31, ahf = (ar >> 2) & 1, aidx = ((ar >> 3) << 2) | (ar & 3);
        bf16x8 apre[4]; u32x2 upre4[4][2];
#pragma unroll
        for (int i = 0; i < 4; ++i) { apre[i] = *(const bf16x8*)(U + (size_t)((2 * cp + ahf) * 64 + 16 * i + aidx) * DM + g * 16 + half * 8);
            if (MAIN) {
#pragma unroll
                for (int th = 0; th < 2; ++th) upre4[i][th] = *(const u32x2*)(U + (size_t)((2 * cp + th) * 64 + 16 * i + (lane & 15)) * DM + g * 16 + (lane >> 4) * 4); } }
#pragma unroll
        for (int i = 0; i < 4; ++i) {
            const bf16x8 a = apre[i];
            f32x16 are[2], aim[2];
#pragma unroll
            for (int s = 0; s < 2; ++s) { f32x16 z;
#pragma unroll
                for (int j = 0; j < 16; ++j) z[j] = 0.f;
                are[s] = __builtin_amdgcn_mfma_f32_32x32x16_bf16(a, Bre[s], z, 0, 0, 0); aim[s] = __builtin_amdgcn_mfma_f32_32x32x16_bf16(a, Bim[s], z, 0, 0, 0); }
#pragma unroll
            for (int j = 0; j < 16; ++j) {
#pragma unroll
                for (int s = 0; s < 2; ++s) { const float nr = lr[s] * xr[s] - li[s] * xi[s] + are[s][j], ni = lr[s] * xi[s] + li[s] * xr[s] + aim[s][j]; xr[s] = nr; xi[s] = ni; }
                if (MAIN) { u32x2 o; o.x = cvt_pk_bf16(xr[0], xr[1]); o.y = cvt_pk_bf16(xi[0], xi[1]); *(u32x2*)(wl + (half * 16 + j) * 272 + sc * 8) = o; }
            }
            if (MAIN) {
                wave_lds_sync();
                const int q8 = lane >> 4, tk = lane & 15;
#pragma unroll
                for (int th = 0; th < 2; ++th) {
                    f32x4 y = (f32x4){0.f, 0.f, 0.f, 0.f};
#pragma unroll
                    for (int ks = 0; ks < 4; ++ks) { const bf16x8 bfrag = *(const bf16x8*)(wl + (th * 16 + tk) * 272 + ks * 64 + q8 * 16); y = __builtin_amdgcn_mfma_f32_16x16x32_bf16(Cm[ks], bfrag, y, 0, 0, 0); }
                    const size_t idx = (size_t)((2 * cp + th) * 64 + 16 * i + tk) * DM + g * 16 + q8 * 4;
                    const u32x2 uu = upre4[i][th];
                    const float y0 = gelu_tanh(y[0] + dsk[0] * bf_lo(uu.x)), y1 = gelu_tanh(y[1] + dsk[1] * bf_hi(uu.x)), y2 = gelu_tanh(y[2] + dsk[2] * bf_lo(uu.y)), y3 = gelu_tanh(y[3] + dsk[3] * bf_hi(uu.y));
                    u32x2 o; o.x = cvt_pk_bf16(y0, y1); o.y = cvt_pk_bf16(y2, y3); *(u32x2*)(G + idx) = o;
                }
                wave_lds_sync();
            }
        }
        if (!MAIN) {
#pragma unroll
            for (int s = 0; s < 2; ++s) EEND[(size_t)(2 * cp + half) * 4096 + g * 64 + sc + 32 * s] = make_float2(xr[s], xi[s]);
        }
    }
}
__device__ __forceinline__ void phase_s5_carry(KP p, unsigned char* shm) {
    const int tid = mytid(), cl = tid & 31, seg = tid >> 5;
    const float2* EEND = (const float2*)(p->ws + WS_EEND); float2* CARRY = (float2*)(p->ws + WS_CARRY);
    float2* segend = (float2*)shm;
    for (int it = mybid(); it < 128; it += gridDim.x) {
        const int chn = it * 32 + cl; float lr, li, cr, ci; s5_lambda(p, chn >> 6, chn & 63, lr, li, cr, ci);
#pragma unroll
        for (int k = 0; k < 6; ++k) { const float a = lr * lr - li * li, b = 2.f * lr * li; lr = a; li = b; }
        float2 e[16];
#pragma unroll
        for (int i = 0; i < 16; ++i) e[i] = EEND[(size_t)(seg * 16 + i) * 4096 + chn];
        float xr = 0.f, xi = 0.f;
#pragma unroll
        for (int i = 0; i < 16; ++i) { const float nr = lr * xr - li * xi + e[i].x, ni = lr * xi + li * xr + e[i].y; xr = nr; xi = ni; }
        __syncthreads();
        segend[seg * 32 + cl] = make_float2(xr, xi);
        __syncthreads();
        float sr = lr, si = li;
#pragma unroll
        for (int k = 0; k < 4; ++k) { const float a = sr * sr - si * si, b = 2.f * sr * si; sr = a; si = b; }
        xr = 0.f; xi = 0.f;
        for (int s2 = 0; s2 < seg; ++s2) { const float2 v = segend[s2 * 32 + cl]; const float nr = sr * xr - si * xi + v.x, ni = sr * xi + si * xr + v.y; xr = nr; xi = ni; }
#pragma unroll
        for (int i = 0; i < 16; ++i) { CARRY[(size_t)(seg * 16 + i) * 4096 + chn] = make_float2(xr, xi); const float nr = lr * xr - li * xi + e[i].x, ni = lr * xi + li * xr + e[i].y; xr = nr; xi = ni; }
    }
}

__device__ __forceinline__ int list_off(int h, int n) { return h * 516096 + 256 * (63 * n - (n * (n - 1)) / 2); }
__device__ __forceinline__ void phase_qknorm(KP p, unsigned char* shm) {
    const int tid = mytid(), wave = tid >> 6, lane = tid & 63;
    const bf16_t* QRAW = (const bf16_t*)(p->ws + WS_QRAW); const bf16_t* VRAW = (const bf16_t*)(p->ws + WS_VRAW);
    bf16_t* QN = (bf16_t*)p->out; bf16_t* KN = (bf16_t*)(p->ws + WS_KN); bf16_t* VT = (bf16_t*)(p->ws + WS_VT); float* KMEAN = (float*)(p->ws + WS_KMEAN);
    const f32x4* ROPE = (const f32x4*)(p->ws + WS_ROPE);
    float* red = (float*)(shm + 256 * 272);
    const float gq0 = p->q_gain[2 * lane], gq1 = p->q_gain[2 * lane + 1], gk0 = p->k_gain[2 * lane], gk1 = p->k_gain[2 * lane + 1];
    for (int it = mybid(); it < 512; it += gridDim.x) {
        const int h = it & 7, n = it >> 3;
        float ka0 = 0.f, ka1 = 0.f;
        const size_t base = ((size_t)h * S + n * 256 + wave * 32) * 128 + 2 * lane;
        unsigned qv[8], kv[8]; f32x4 cs[8];
#pragma unroll
        for (int j = 0; j < 8; ++j) { qv[j] = *(const unsigned*)(QRAW + base + (size_t)j * 128); kv[j] = *(const unsigned*)(KN + base + (size_t)j * 128); cs[j] = ROPE[(size_t)(n * 256 + wave * 32 + j) * 8 + (lane & 7)]; }
        for (int g4 = 0; g4 < 4; ++g4) {
            unsigned qn_[8], kn_[8]; f32x4 cn_[8];
            if (g4 < 3) {
#pragma unroll
                for (int j = 0; j < 8; ++j) { const int rr = (g4 + 1) * 8 + j; qn_[j] = *(const unsigned*)(QRAW + base + (size_t)rr * 128); kn_[j] = *(const unsigned*)(KN + base + (size_t)rr * 128); cn_[j] = ROPE[(size_t)(n * 256 + wave * 32 + rr) * 8 + (lane & 7)]; }
            }
#pragma unroll
            for (int j = 0; j < 8; ++j) {
                const size_t idx = base + (size_t)(g4 * 8 + j) * 128;
                float q0 = bf_lo(qv[j]), q1 = bf_hi(qv[j]), k0 = bf_lo(kv[j]), k1 = bf_hi(kv[j]);
                const float rq = rsqrtf(wave_sum(q0 * q0 + q1 * q1) * (1.f / 128.f) + EPS), rk = rsqrtf(wave_sum(k0 * k0 + k1 * k1) * (1.f / 128.f) + EPS);
                q0 *= rq * gq0; q1 *= rq * gq1; k0 *= rk * gk0; k1 *= rk * gk1;
                const float pq0 = __shfl_xor(q0, 8), pq1 = __shfl_xor(q1, 8), pk0 = __shfl_xor(k0, 8), pk1 = __shfl_xor(k1, 8);
                if (lane < 16) {
                    const float c0 = cs[j][0], s0 = cs[j][1], c1 = cs[j][2], s1 = cs[j][3];
                    const float sg = lane < 8 ? -1.f : 1.f;
                    q0 = q0 * c0 + sg * pq0 * s0; q1 = q1 * c1 + sg * pq1 * s1; k0 = k0 * c0 + sg * pk0 * s0; k1 = k1 * c1 + sg * pk1 * s1;
                }
                *(unsigned*)(QN + idx) = cvt_pk_bf16(q0 * 0.1275174308f, q1 * 0.1275174308f);
                *(unsigned*)(KN + idx) = cvt_pk_bf16(k0, k1);
                ka0 += k0; ka1 += k1;
            }
#pragma unroll
            for (int j = 0; j < 8; ++j) { qv[j] = qn_[j]; kv[j] = kn_[j]; cs[j] = cn_[j]; }
        }
        __syncthreads();
        red[wave * 128 + 2 * lane] = ka0; red[wave * 128 + 2 * lane + 1] = ka1;
#pragma unroll
        for (int ps = 0; ps < 8; ++ps) { const int off = (ps * 512 + tid) * 16, key = off >> 8, cb = off & 255;
            *(u32x4*)(shm + key * 272 + cb) = *(const u32x4*)((const unsigned char*)(VRAW + ((size_t)h * S + n * 256) * 128) + off); }
        __syncthreads();
        if (tid < 128) { float s = 0.f;
#pragma unroll
            for (int w = 0; w < 8; ++w) s += red[w * 128 + tid];
            KMEAN[(size_t)(h * 64 + n) * 128 + tid] = s * (1.f / 256.f); }
        { const int d = tid & 127, kq = tid >> 7;
#pragma unroll
            for (int j = 0; j < 8; ++j) { unsigned short e[8];
#pragma unroll
                for (int k = 0; k < 8; ++k) e[k] = *(const unsigned short*)(shm + (kq * 64 + 8 * j + k) * 272 + d * 2);
                u32x4 o; o.x = e[0] | ((unsigned)e[1] << 16); o.y = e[2] | ((unsigned)e[3] << 16); o.z = e[4] | ((unsigned)e[5] << 16); o.w = e[6] | ((unsigned)e[7] << 16);
                *(u32x4*)(VT + ((size_t)(h * 64 + n) * 128 + d) * 256 + kq * 64 + 8 * j) = o; } }
    }
}
__device__ __forceinline__ void phase_gate(KP p, unsigned char* shm) {
    const int tid = mytid(), wave = tid >> 6, lane = tid & 63, qc = lane & 15, q4 = lane >> 4;
    const bf16_t* QN = (const bf16_t*)p->out; const float* KMEAN = (const float*)(p->ws + WS_KMEAN);
    int* CNT = (int*)(p->ws + WS_CNT); unsigned* LISTS = (unsigned*)(p->ws + WS_LISTS);
    int* cntl = (int*)shm; int* basel = cntl + 64;
    for (int it = mybid(); it < 1024; it += gridDim.x) {
        const int h = it & 7, c = it >> 3, own = c >> 1;
        __syncthreads();
        if (tid < 64) cntl[tid] = 0;
        __syncthreads();
        const int row = c * 128 + wave * 16 + qc;
        bf16x8 Qf[4];
#pragma unroll
        for (int ks = 0; ks < 4; ++ks) Qf[ks] = *(const bf16x8*)(QN + ((size_t)h * S + row) * 128 + ks * 32 + q4 * 8);
        const int nbt = (own + 15) >> 4;
        f32x4 gacc[4];
#pragma unroll
        for (int bt = 0; bt < 4; ++bt) {
            gacc[bt] = (f32x4){0.f, 0.f, 0.f, 0.f};
            if (bt < nbt) {
#pragma unroll
                for (int ks = 0; ks < 4; ++ks) {
                    const f32x4* kp = (const f32x4*)(KMEAN + (size_t)(h * 64 + bt * 16 + qc) * 128 + ks * 32 + q4 * 8); const f32x4 a = kp[0], b = kp[1];
                    u32x4 hi; hi.x = cvt_pk_bf16(a[0], a[1]); hi.y = cvt_pk_bf16(a[2], a[3]); hi.z = cvt_pk_bf16(b[0], b[1]); hi.w = cvt_pk_bf16(b[2], b[3]);
                    u32x4 lo; lo.x = cvt_pk_bf16(a[0] - bf_lo(hi.x), a[1] - bf_hi(hi.x)); lo.y = cvt_pk_bf16(a[2] - bf_lo(hi.y), a[3] - bf_hi(hi.y));
                    lo.z = cvt_pk_bf16(b[0] - bf_lo(hi.z), b[1] - bf_hi(hi.z)); lo.w = cvt_pk_bf16(b[2] - bf_lo(hi.w), b[3] - bf_hi(hi.w));
                    gacc[bt] = __builtin_amdgcn_mfma_f32_16x16x32_bf16(__builtin_bit_cast(bf16x8, hi), Qf[ks], gacc[bt], 0, 0, 0);
                    gacc[bt] = __builtin_amdgcn_mfma_f32_16x16x32_bf16(__builtin_bit_cast(bf16x8, lo), Qf[ks], gacc[bt], 0, 0, 0);
                }
            }
        }
        const float NINF = -__builtin_inff();
        float v0 = NINF, v1 = NINF, v2 = NINF; int i0 = 1000 + q4, i1 = 2000 + q4, i2 = 3000 + q4;
#pragma unroll
        for (int bt = 0; bt < 4; ++bt)
#pragma unroll
            for (int j = 0; j < 4; ++j) { const int n = bt * 16 + q4 * 4 + j; const float v = gacc[bt][j];
                if (n < own) {
                    if (v > v0) { v2 = v1; i2 = i1; v1 = v0; i1 = i0; v0 = v; i0 = n; }
                    else if (v > v1) { v2 = v1; i2 = i1; v1 = v; i1 = n; }
                    else if (v > v2) { v2 = v; i2 = n; } } }
        int sel[3];
#pragma unroll
        for (int j = 0; j < 3; ++j) { float bv = v0; int bi = i0;
#pragma unroll
            for (int o = 16; o < 64; o <<= 1) { const float ov = __shfl_xor(bv, o); const int oi = __shfl_xor(bi, o); if (ov > bv || (ov == bv && oi < bi)) { bv = ov; bi = oi; } }
            sel[j] = bi; if (bi == i0) { v0 = v1; i0 = i1; v1 = v2; i1 = i2; v2 = NINF; i2 = 4000 + q4; } }
        const int ns = own < 3 ? own : 3; int lpos[3] = {0, 0, 0};
        if (q4 == 0) {
#pragma unroll
            for (int j = 0; j < 3; ++j) if (j < ns) lpos[j] = atomicAdd(&cntl[sel[j]], 1);
        }
        __syncthreads();
        if (tid < 64) { const int cn = cntl[tid]; if (cn > 0) basel[tid] = atomicAdd(&CNT[h * 64 + tid], cn); }
        __syncthreads();
        if (q4 == 0) {
#pragma unroll
            for (int j = 0; j < 3; ++j) if (j < ns) LISTS[list_off(h, sel[j]) + basel[sel[j]] + lpos[j]] = ((unsigned)row << 2) | (unsigned)j;
        }
    }
}
struct AttnItem { int h, n, tile, cnt; };
template <bool OWN>
__device__ __forceinline__ AttnItem attn_decode(int it, const int* pre, const int* cnts) {
    AttnItem a;
    if (OWN) { a.h = it & 7; a.n = it >> 3; a.tile = a.n; a.cnt = 0; }
    else { int lo = 0, hi = 511; while (lo < hi) { const int mid = (lo + hi + 1) >> 1; if (pre[mid] <= it) lo = mid; else hi = mid - 1; }
        a.h = lo >> 6; a.n = lo & 63; a.tile = it - pre[lo]; a.cnt = cnts[lo]; }
    return a;
}
template <bool OWN>
__device__ __forceinline__ void phase_attn(KP p, unsigned char* shm) {
    const int tid = mytid(), wave = tid >> 6, lane = tid & 63, qc = lane & 15, q4 = lane >> 4;
    const bf16_t* QN = (const bf16_t*)p->out; const bf16_t* KN = (const bf16_t*)(p->ws + WS_KN); const bf16_t* VT = (const bf16_t*)(p->ws + WS_VT);
    bf16_t* OPART = (bf16_t*)(p->ws + WS_OPART); float* LPART = (float*)(p->ws + WS_LPART); const unsigned* LISTS = (const unsigned*)(p->ws + WS_LISTS);
    const float Msh = *(const float*)(p->ws + WS_MSH);
    unsigned char* Kl = shm; unsigned char* Vl = shm + 256 * 272;
    int* pre = (int*)(shm + 256 * 272 + 128 * 528); int* cnts = pre + 516;
    int total = 512;
    if (!OWN) {
        const int* CNT = (const int*)(p->ws + WS_CNT);
        const int mycnt = CNT[tid]; cnts[tid] = mycnt;
        pre[tid + 1] = (mycnt + 255) >> 8; if (tid == 0) pre[0] = 0;
        __syncthreads();
        for (int o = 1; o < 512; o <<= 1) { const int v = pre[tid + 1] + (tid >= o ? pre[tid + 1 - o] : 0); __syncthreads(); pre[tid + 1] = v; __syncthreads(); }
        total = pre[512];
    }
    const int G = gridDim.x;
    const int ipb = OWN ? 1 : (total + G - 1) / G;
    const int step = OWN ? G : 1;
    int it = OWN ? mybid() : mybid() * ipb;
    const int it_end = OWN ? total : (it + ipb < total ? it + ipb : total);
    if (it >= it_end) return;
    AttnItem cur = attn_decode<OWN>(it, pre, cnts);
    const int r0 = wave * 32 + qc;
    unsigned ecur[2] = {0u, 0u}, enext[2] = {0u, 0u};
    if (!OWN) {
#pragma unroll
        for (int gq = 0; gq < 2; ++gq) { const int idx = cur.tile * 256 + r0 + 16 * gq; ecur[gq] = idx < cur.cnt ? (LISTS[list_off(cur.h, cur.n) + idx] | 0x80000000u) : 0u; }
        if (it + step < it_end) { const AttnItem nx = attn_decode<OWN>(it + step, pre, cnts);
#pragma unroll
            for (int gq = 0; gq < 2; ++gq) { const int i2 = nx.tile * 256 + r0 + 16 * gq; enext[gq] = i2 < nx.cnt ? (LISTS[list_off(nx.h, nx.n) + i2] | 0x80000000u) : 0u; } }
    }
    u32x4 kv[12]; bf16x8 Qf[2][4];
    {
#pragma unroll
        for (int gq = 0; gq < 2; ++gq) { const int qrow = OWN ? cur.tile * 256 + r0 + 16 * gq : (int)((ecur[gq] & 0x7fffffffu) >> 2);
#pragma unroll
            for (int ks = 0; ks < 4; ++ks) Qf[gq][ks] = *(const bf16x8*)(QN + ((size_t)cur.h * S + qrow) * 128 + ks * 32 + q4 * 8); }
        const unsigned char* kg_ = (const unsigned char*)(KN + ((size_t)cur.h * S + cur.n * 256) * 128); const unsigned char* vg_ = (const unsigned char*)(VT + (size_t)(cur.h * 64 + cur.n) * 128 * 256);
#pragma unroll
        for (int ps = 0; ps < 8; ++ps) { kv[ps] = *(const u32x4*)(kg_ + (ps * 512 + tid) * 16); if (ps < 4) kv[8 + ps] = *(const u32x4*)(vg_ + (ps * 512 + tid) * 16); } }
    bool fill = true;
    for (;;) {
        if (fill) {
        __syncthreads();
        { u32x4 v2[4]; const unsigned char* vg_ = (const unsigned char*)(VT + (size_t)(cur.h * 64 + cur.n) * 128 * 256);
#pragma unroll
            for (int ps = 0; ps < 4; ++ps) v2[ps] = *(const u32x4*)(vg_ + ((4 + ps) * 512 + tid) * 16);
#pragma unroll
            for (int ps = 0; ps < 8; ++ps) { const int off = (ps * 512 + tid) * 16; *(u32x4*)(Kl + (off >> 8) * 272 + (off & 255)) = kv[ps]; if (ps < 4) *(u32x4*)(Vl + (off >> 9) * 528 + (off & 511)) = kv[8 + ps]; }
#pragma unroll
            for (int ps = 0; ps < 4; ++ps) { const int off = ((4 + ps) * 512 + tid) * 16; *(u32x4*)(Vl + (off >> 9) * 528 + (off & 511)) = v2[ps]; } }
        __syncthreads();
        }
        const int itn = it + step; const bool has_next = itn < it_end;
        AttnItem nxt = cur; unsigned enn[2] = {0u, 0u}; bool same = false;
        if (has_next) {
            nxt = attn_decode<OWN>(itn, pre, cnts);
            same = !OWN && nxt.h == cur.h && nxt.n == cur.n;
            const unsigned char* kg_ = (const unsigned char*)(KN + ((size_t)nxt.h * S + nxt.n * 256) * 128); const unsigned char* vg_ = (const unsigned char*)(VT + (size_t)(nxt.h * 64 + nxt.n) * 128 * 256);
            if (!same) {
#pragma unroll
                for (int ps = 0; ps < 8; ++ps) { kv[ps] = *(const u32x4*)(kg_ + (ps * 512 + tid) * 16); if (ps < 4) kv[8 + ps] = *(const u32x4*)(vg_ + (ps * 512 + tid) * 16); } }
            if (!OWN && itn + step < it_end) { const AttnItem n2 = attn_decode<OWN>(itn + step, pre, cnts);
#pragma unroll
                for (int gq = 0; gq < 2; ++gq) { const int i2 = n2.tile * 256 + r0 + 16 * gq; enn[gq] = i2 < n2.cnt ? (LISTS[list_off(n2.h, n2.n) + i2] | 0x80000000u) : 0u; } }
        }
        const int h = cur.h, n = cur.n;
        int qrow[2];
#pragma unroll
        for (int gq = 0; gq < 2; ++gq) qrow[gq] = OWN ? cur.tile * 256 + r0 + 16 * gq : (int)((ecur[gq] & 0x7fffffffu) >> 2);
        float lsum[2] = {0.f, 0.f}; f32x4 o[2][8];
#pragma unroll
        for (int gq = 0; gq < 2; ++gq)
#pragma unroll
            for (int dt = 0; dt < 8; ++dt) o[gq][dt] = (f32x4){0.f, 0.f, 0.f, 0.f};
        const int kg_end = OWN ? wave + 1 : ((cur.tile * 256 + wave * 32 < cur.cnt) ? 8 : 0);
#pragma unroll 2
        for (int kg = 0; kg < kg_end; ++kg) {
            f32x4 sa[2], sb[2];
#pragma unroll
            for (int gq = 0; gq < 2; ++gq) { sa[gq] = (f32x4){-Msh, -Msh, -Msh, -Msh}; sb[gq] = sa[gq]; }
            const int key_a = kg * 32 + (qc >> 2) * 8 + (qc & 3);
#pragma unroll
            for (int ks = 0; ks < 4; ++ks) { const bf16x8 Ka = *(const bf16x8*)(Kl + key_a * 272 + (ks * 32 + q4 * 8) * 2), Kb = *(const bf16x8*)(Kl + (key_a + 4) * 272 + (ks * 32 + q4 * 8) * 2);
#pragma unroll
                for (int gq = 0; gq < 2; ++gq) { sa[gq] = __builtin_amdgcn_mfma_f32_16x16x32_bf16(Ka, Qf[gq][ks], sa[gq], 0, 0, 0); sb[gq] = __builtin_amdgcn_mfma_f32_16x16x32_bf16(Kb, Qf[gq][ks], sb[gq], 0, 0, 0); } }
            bf16x8 P[2];
#pragma unroll
            for (int gq = 0; gq < 2; ++gq) {
                float pv[8];
#pragma unroll
                for (int j = 0; j < 4; ++j) { pv[j] = __builtin_amdgcn_exp2f(sa[gq][j]); pv[4 + j] = __builtin_amdgcn_exp2f(sb[gq][j]); }
                if (OWN) {
#pragma unroll
                    for (int j = 0; j < 8; ++j) { const int kpos = n * 256 + kg * 32 + q4 * 8 + j; if (kpos > qrow[gq]) pv[j] = 0.f; }
                }
#pragma unroll
                for (int j = 0; j < 8; ++j) lsum[gq] += pv[j];
                u32x4 pk; pk.x = cvt_pk_bf16(pv[0], pv[1]); pk.y = cvt_pk_bf16(pv[2], pv[3]); pk.z = cvt_pk_bf16(pv[4], pv[5]); pk.w = cvt_pk_bf16(pv[6], pv[7]);
                P[gq] = __builtin_bit_cast(bf16x8, pk);
            }
#pragma unroll
            for (int dt = 0; dt < 8; ++dt) { const bf16x8 Vf = *(const bf16x8*)(Vl + (dt * 16 + qc) * 528 + (kg * 32 + q4 * 8) * 2);
#pragma unroll
                for (int gq = 0; gq < 2; ++gq) o[gq][dt] = __builtin_amdgcn_mfma_f32_16x16x32_bf16(Vf, P[gq], o[gq][dt], 0, 0, 0); }
        }
        if (has_next) {
#pragma unroll
            for (int gq = 0; gq < 2; ++gq) { const int qr = OWN ? nxt.tile * 256 + r0 + 16 * gq : (int)((enext[gq] & 0x7fffffffu) >> 2);
#pragma unroll
                for (int ks = 0; ks < 4; ++ks) Qf[gq][ks] = *(const bf16x8*)(QN + ((size_t)nxt.h * S + qr) * 128 + ks * 32 + q4 * 8); }
        }
#pragma unroll
        for (int gq = 0; gq < 2; ++gq) {
            float ls = lsum[gq]; ls += __shfl_xor(ls, 16); ls += __shfl_xor(ls, 32);
            const int qr = qrow[gq];
            if (OWN) {
                const int own = n, ns = own < 3 ? own : 3;
                for (int s = 0; s < ns; ++s) { ls += LPART[((size_t)qr * 8 + h) * 3 + s];
#pragma unroll
                    for (int dt = 0; dt < 8; ++dt) { const u32x2 v = *(const u32x2*)(OPART + (((size_t)qr * 3 + s) * 8 + h) * 128 + dt * 16 + q4 * 4); o[gq][dt][0] += bf_lo(v.x); o[gq][dt][1] += bf_hi(v.x); o[gq][dt][2] += bf_lo(v.y); o[gq][dt][3] += bf_hi(v.y); } }
                const float inv = 1.f / ls;
#pragma unroll
                for (int dt = 0; dt < 8; ++dt) { u32x2 v; v.x = cvt_pk_bf16(o[gq][dt][0] * inv, o[gq][dt][1] * inv); v.y = cvt_pk_bf16(o[gq][dt][2] * inv, o[gq][dt][3] * inv); *(u32x2*)(OPART + (((size_t)qr * 3) * 8 + h) * 128 + dt * 16 + q4 * 4) = v; }
            } else if ((ecur[gq] >> 31) != 0u) {
                const int slot = (int)(ecur[gq] & 3u);
#pragma unroll
                for (int dt = 0; dt < 8; ++dt) { u32x2 v; v.x = cvt_pk_bf16(o[gq][dt][0] * 1.f, o[gq][dt][1] * 1.f); v.y = cvt_pk_bf16(o[gq][dt][2] * 1.f, o[gq][dt][3] * 1.f); *(u32x2*)(OPART + (((size_t)qr * 3 + slot) * 8 + h) * 128 + dt * 16 + q4 * 4) = v; }
                if (q4 == 0) LPART[((size_t)qr * 8 + h) * 3 + slot] = ls;
            }
        }
        if (!has_next) break;
        it = itn; cur = nxt; fill = !same;
#pragma unroll
        for (int gq = 0; gq < 2; ++gq) { ecur[gq] = enext[gq]; enext[gq] = enn[gq]; }
    }
}

#define XB_TMO      128
#define XB_XCNT(j)  (256  + 64 * (j))
#define XB_XSUB(j)  (1280 + 64 * (j))
#define XB_XGEN(j)  (2304 + 64 * (j))
#define XB_TOP      3328
#define XB_TOPGEN   3392
#define XCD_BAR_WORDS 3456
#define XB_SPIN_CAP (1u << 18)
__device__ __forceinline__ unsigned xb_ld(unsigned* p)              { return __hip_atomic_load(p, __ATOMIC_RELAXED, __HIP_MEMORY_SCOPE_AGENT); }
__device__ __forceinline__ unsigned xb_add(unsigned* p, unsigned v) { return __hip_atomic_fetch_add(p, v, __ATOMIC_RELAXED, __HIP_MEMORY_SCOPE_AGENT); }
__device__ __forceinline__ unsigned xb_xcc_id() { return (unsigned)__builtin_amdgcn_s_getreg((3 << 11) | 20) & 0xFu; }
#define XB_SPIN(cond, bar) do { unsigned _sp = 0; while (cond) { __builtin_amdgcn_s_sleep(1); \
    if ((++_sp & 255u) == 0u) { if (xb_ld(&(bar)[XB_TMO])) break; if (_sp > XB_SPIN_CAP) { atomicAdd(&(bar)[XB_TMO], 1u); break; } } } } while (0)
struct XcdBarrier { unsigned* bar; unsigned x; volatile LAS unsigned* st; };
__device__ __forceinline__ void xcd_barrier_post(unsigned* bar) { if (threadIdx.x == 0) (void)xb_add(&bar[XB_XCNT(xb_xcc_id())], 1u); }
__device__ __forceinline__ void xcd_barrier_complete(unsigned* bar, unsigned x, unsigned& nloc, unsigned& nx) {
    const unsigned G = gridDim.x * gridDim.y * gridDim.z;
    unsigned sum, cnt, mine, sp = 0u;
    for (;;) {
        sum = 0u; cnt = 0u; mine = 0u;
#pragma unroll
        for (unsigned j = 0; j < 16; ++j) { const unsigned c = xb_ld(&bar[XB_XCNT(j)]); sum += c; cnt += (c > 0u) ? 1u : 0u; mine = (j == x) ? c : mine; }
        if (sum == G) break;
        __builtin_amdgcn_s_sleep(1);
        if ((++sp & 255u) == 0u) { if (xb_ld(&bar[XB_TMO])) break; if (sp > XB_SPIN_CAP) { atomicAdd(&bar[XB_TMO], 1u); break; } }
    }
    nloc = mine > 0u ? mine : 1u; nx = cnt > 0u ? cnt : 1u;
}
__device__ __forceinline__ void xcd_barrier(unsigned* bar_, volatile LAS unsigned* st_) {
    asm volatile("s_waitcnt vmcnt(0)" ::: "memory");
    __syncthreads();
    if (threadIdx.x == 0) {
        unsigned* bar = bar_; XcdBarrier b; b.bar = bar_; b.x = xb_xcc_id(); b.st = st_;
        __builtin_amdgcn_s_waitcnt(0);
        unsigned nloc = b.st[0], nx = b.st[1];
        if (nloc == 0u) { xcd_barrier_complete(bar, b.x, nloc, nx); b.st[0] = nloc; b.st[1] = nx; }
        const unsigned old = xb_add(&bar[XB_XSUB(b.x)], 1u);
        const unsigned gen = old / nloc;
        if (old + 1u == (gen + 1u) * nloc) {
            __builtin_amdgcn_fence(__ATOMIC_RELEASE, "agent");
            asm volatile("s_waitcnt vmcnt(0)" ::: "memory");
            const unsigned og = xb_add(&bar[XB_TOP], 1u);
            const unsigned tg = og / nx;
            if (og + 1u == (tg + 1u) * nx) xb_add(&bar[XB_TOPGEN], 1u);
            else XB_SPIN(xb_ld(&bar[XB_TOPGEN]) == tg, bar);
            __builtin_amdgcn_fence(__ATOMIC_ACQUIRE, "agent");
            xb_add(&bar[XB_XGEN(b.x)], 1u);
            asm volatile("s_waitcnt vmcnt(0)" ::: "memory");
        } else {
            XB_SPIN(xb_ld(&bar[XB_XGEN(b.x)]) == gen, bar);
            __builtin_amdgcn_fence(__ATOMIC_ACQUIRE, "agent");
            asm volatile("s_waitcnt vmcnt(0)" ::: "memory");
        }
    }
    __syncthreads();
}

__global__ void __launch_bounds__(512, 2) mk_fwd(Params p_unused) {
    extern __shared__ __attribute__((aligned(16))) unsigned char shm[];
    cg::grid_group grid = cg::this_grid();
    volatile LAS unsigned* xst = (volatile LAS unsigned*)((LAS unsigned char*)shm + (LDS_BYTES - 16));
    if (threadIdx.x == 0) { xst[0] = 0u; xst[1] = 0u; }
    __syncthreads();
    { KP p0 = (KP)__builtin_amdgcn_kernarg_segment_ptr(); unsigned* bw = (unsigned*)(p0->ws + WS_BAR);
      if (blockIdx.x == 0) for (int i = threadIdx.x; i < XCD_BAR_WORDS; i += 512) bw[i] = 0u; }
    int rep = 0; (void)rep;
    for (int ph = 0; ph <= 20; ++ph) {
        KP p = (KP)__builtin_amdgcn_kernarg_segment_ptr(); asm volatile("" : "+s"(p));
        unsigned char* ws = p->ws;
        float* rowss = (float*)(ws + WS_SSP); bf16_t* HB = (bf16_t*)(ws + WS_HB);
        switch (ph) {
        case 0: phase_prep(p, shm); break;
        case 1: case 9: case 11: case 19: {
            const int f = ph == 1 ? 0 : (ph == 9 ? 1 : (ph == 11 ? 2 : 3));
            const size_t wo = f == 0 ? W0_GU0 : (f == 1 ? W0_GU1 : (f == 2 ? W1_GU0 : W1_GU1));
            pg8::Gemm g{HB, (const bf16_t*)(ws + wo), S, 2 * FF, DM, DM}; pg8::StaticOrder so; so.init(S, 2 * FF, gridDim.x, mybid());
            const int pm0 = rs_table_build(shm, rowss, 2 * FF);
            EpiGU e{(bf16_t*)(ws + WS_ACT), rowss, (const float*)(shm + RS_LDS_OFF), pm0};
            pg8::gemm_phase(( LAS unsigned char*)shm, g, so, e);
            if (ph != 19) {
                const int stage = ph == 1 ? 1 : (ph == 9 ? 2 : 3); const int c = mybid(), wv = mytid() >> 6;
                if (gridDim.x == 256) { if (c >= 128) prep_weights(p, shm, stage, (c - 128) * 8 + wv, 1024); }
                else prep_weights(p, shm, stage, c * 8 + wv, gridDim.x * 8);
            } } break;
        case 2: case 10: case 12: case 20: case 8: case 18: {
            const bf16_t* A; const bf16_t* Bt; int K, lda; float w = 0.5f; int so_i;
            if (ph == 2) { A = (const bf16_t*)(ws + WS_ACT); Bt = (const bf16_t*)(ws + W0_D0); K = FF; lda = FF; so_i = 1; }
            else if (ph == 10) { A = (const bf16_t*)(ws + WS_ACT); Bt = (const bf16_t*)(ws + W0_D1); K = FF; lda = FF; so_i = 3; }
            else if (ph == 12) { A = (const bf16_t*)(ws + WS_ACT); Bt = (const bf16_t*)(ws + W1_D0); K = FF; lda = FF; so_i = 4; }
            else if (ph == 20) { A = (const bf16_t*)(ws + WS_ACT); Bt = (const bf16_t*)(ws + W1_D1); K = FF; lda = FF; so_i = -1; }
            else if (ph == 8) { A = (const bf16_t*)(ws + WS_U); Bt = (const bf16_t*)(ws + W0_OUT); K = DM; lda = DM; w = 1.f; so_i = 2; }
            else { A = (const bf16_t*)(ws + WS_OPART); Bt = (const bf16_t*)(ws + W1_MO); K = DM; lda = 3 * DM; w = 1.f; so_i = 5; }
            pg8::Gemm g{A, Bt, S, DM, K, lda}; pg8::StaticOrder so; so.init(S, DM, gridDim.x, mybid());
            EpiRes e{so_i >= 0 ? nullptr : p->out, HB, rowss, w};
            pg8::gemm_phase((LAS unsigned char*)shm, g, so, e); } break;
        case 3: { pg8::Gemm g{HB, (const bf16_t*)(ws + W0_IN), S, DM, DM, DM}; pg8::StaticOrder so; so.init(S, DM, gridDim.x, mybid());
            const int pm0 = rs_table_build(shm, rowss, DM);
            EpiU e{(bf16_t*)(ws + WS_U), rowss, (const float*)(shm + RS_LDS_OFF), pm0}; pg8::gemm_phase((LAS unsigned char*)shm, g, so, e); } break;
        case 4: phase_s5_scan<false>(p, shm); break;
        case 5: phase_s5_carry(p, shm); break;
        case 6: phase_s5_scan<true>(p, shm); break;
        case 7: { pg8::Gemm g{(const bf16_t*)(ws + WS_G), (const bf16_t*)(ws + W0_GLU), S, DM, DM, DM}; pg8::StaticOrder so; so.init(S, DM, gridDim.x, mybid());
            EpiGLU e{(const bf16_t*)(ws + WS_G), (bf16_t*)(ws + WS_U)}; pg8::gemm_phase((LAS unsigned char*)shm, g, so, e); } break;
        case 13: { pg8::Gemm g{HB, (const bf16_t*)(ws + W1_QKV), S, 3 * DM, DM, DM}; pg8::StaticOrder so; so.init(S, 3 * DM, gridDim.x, mybid());
            const int pm0 = rs_table_build(shm, rowss, 3 * DM);
            EpiQKV e{ws, rowss, (const float*)(shm + RS_LDS_OFF), pm0}; pg8::gemm_phase((LAS unsigned char*)shm, g, so, e); } break;
        case 14: phase_qknorm(p, shm); break;
        case 15: phase_gate(p, shm); break;
        case 16: phase_attn<false>(p, shm); break;
        case 17: phase_attn<true>(p, shm); break;
        }
        if (ph == 0) { grid.sync(); xcd_barrier_post((unsigned*)(ws + WS_BAR)); } else if (ph < 20) xcd_barrier((unsigned*)(ws + WS_BAR), xst);
#ifdef PROBE_PH
        if (ph == PROBE_PH && rep < PROBE_N) { ++rep; --ph; }
#endif
#ifdef PROBE_SYNC
        if (ph == 0) for (int k = 0; k < PROBE_SYNC; ++k) xcd_barrier((unsigned*)(ws + WS_BAR), xst);
#endif
    }
}

extern "C" void kernel_launch(void* const* d_in, const int* in_sizes, int n_in, void* d_out, int out_size, void* d_ws, size_t ws_size, hipStream_t stream) {
    static int grid_blocks = 0;
    if (!grid_blocks) {
        int dev = 0, cus = 0, per_cu = 0;
        (void)hipGetDevice(&dev);
        (void)hipDeviceGetAttribute(&cus, hipDeviceAttributeMultiprocessorCount, dev);
        (void)hipFuncSetAttribute((const void*)mk_fwd, hipFuncAttributeMaxDynamicSharedMemorySize, LDS_BYTES);
        (void)hipOccupancyMaxActiveBlocksPerMultiprocessor(&per_cu, (const void*)mk_fwd, 512, LDS_BYTES);
        if (per_cu < 1) per_cu = 1;
        grid_blocks = cus * per_cu;
        grid_blocks -= grid_blocks % 8;
        if (ws_size < 254 * MiB) fprintf(stderr, "kernel_launch: workspace too small: %zu\n", ws_size);
    }
    Params p{};
    const float** pp = (const float**)&p;
    for (int i = 0; i < 21; ++i) pp[i] = (const float*)d_in[i];
    p.out = (float*)d_out; p.ws = (unsigned char*)d_ws;
    for (int k = 0; k < 16; ++k) p.invf[k] = (float)pow(500000.0, -(double)k / 16.0);
    void* args[] = {&p};
    hipError_t e = hipLaunchCooperativeKernel((const void*)mk_fwd, dim3(grid_blocks), dim3(512), args, LDS_BYTES, stream);
    if (e != hipSuccess) fprintf(stderr, "cooperative launch failed: %s (grid %d)\n", hipGetErrorString(e), grid_blocks);
}
```
